# Optimizing an MI355X kernel written in HIP

```python
import math
import jax, jax.numpy as jnp
from jax import lax
import numpy as np

D_MODEL = 2048
BATCH = 32
SEQ = 256
DEPTH = 1
DEC_BATCH = 2
DEC_SEQ = 1024
PAST_LEN = 256

GRID_W = 64
D_SSM = 1024
SSM_CH = 16
SSM_GROUPS = D_SSM // SSM_CH
SSM_STATE = 64
N_HEADS = 8
N_KV_HEADS = 2
HEAD_DIM = 128
Q_PER_KV = N_HEADS // N_KV_HEADS
D_ATTN = N_HEADS * HEAD_DIM
D_KV = N_KV_HEADS * HEAD_DIM
WINDOW = 128
BLOCK = 128
D_FF = 5632
CONV_WIDTH = 3
ROPE_THETA = 10000.0
EPS = 1e-6
NEG_INF = -1e30
IN_COLS = D_SSM + D_ATTN + 2 * D_KV + 2 * D_MODEL

kernel_name = 'hybrid_s5_swa_prefix_dit_step'


def rmsnorm(x, g):
    xf = x.astype(jnp.float32)
    y = xf * lax.rsqrt(jnp.mean(xf * xf, axis=-1, keepdims=True) + EPS)
    return (y * g.astype(jnp.float32)).astype(x.dtype)


def adaln(cond, w, b):
    m = jax.nn.silu(cond) @ w + b
    if m.ndim == 2:
        m = m[:, None, :]
    return jnp.split(m, 6, axis=-1)


def axial_rope_tables(T):
    rows = T // GRID_W
    row = jnp.repeat(jnp.arange(rows, dtype=jnp.float32), GRID_W)
    col = jnp.tile(jnp.arange(GRID_W, dtype=jnp.float32), rows)
    n_freq = HEAD_DIM // 4
    inv = ROPE_THETA ** (-jnp.arange(n_freq, dtype=jnp.float32) / n_freq)
    ang_r = row[:, None] * inv[None, :]
    ang_c = col[:, None] * inv[None, :]
    return (jnp.cos(ang_r), jnp.sin(ang_r), jnp.cos(ang_c), jnp.sin(ang_c))


def rotate_half(x, cos, sin):
    x1, x2 = jnp.split(x, 2, axis=-1)
    return jnp.concatenate([x1 * cos - x2 * sin, x1 * sin + x2 * cos], axis=-1)


def apply_axial_rope(x, tables):
    cos_r, sin_r, cos_c, sin_c = tables
    shp = (cos_r.shape[0],) + (1,) * (x.ndim - 3) + (cos_r.shape[1],)
    xr, xc = jnp.split(x.astype(jnp.float32), 2, axis=-1)
    out = jnp.concatenate([rotate_half(xr, cos_r.reshape(shp), sin_r.reshape(shp)),
                           rotate_half(xc, cos_c.reshape(shp), sin_c.reshape(shp))], axis=-1)
    return out.astype(x.dtype)


def ssm_discretize(lam_re, lam_im, log_dt, b_re, b_im):
    lam = lax.complex(lam_re.astype(jnp.float32), lam_im.astype(jnp.float32))
    dt = jnp.exp(log_dt.astype(jnp.float32))[:, None]
    lam_bar = jnp.exp(lam * dt)
    bmat = lax.complex(b_re.astype(jnp.float32), b_im.astype(jnp.float32))
    b_bar = ((lam_bar - 1.0) / lam)[..., None] * bmat
    return lam_bar, b_bar


def scan_combine(e1, e2):
    a1, b1 = e1
    a2, b2 = e2
    return a1 * a2, a2 * b1 + b2


def ssm_scan(u_g, lam_bar, b_bar, h0, reverse):
    bu = jnp.einsum('gpc,btgc->btgp', b_bar, u_g.astype(jnp.complex64))
    edge = -1 if reverse else 0
    bu = bu.at[:, edge].add(lam_bar[None] * h0)
    a = jnp.broadcast_to(lam_bar, bu.shape)
    _, h = lax.associative_scan(scan_combine, (a, bu), axis=1, reverse=reverse)
    return h


def ssm_branch(u, p, h0_re, h0_im):
    bsz, T, _ = u.shape
    uf = u.astype(jnp.float32)
    ug = uf.reshape(bsz, T, SSM_GROUPS, SSM_CH)
    h0 = lax.complex(h0_re.astype(jnp.float32), h0_im.astype(jnp.float32))
    y = uf * p['ssm_d'].astype(jnp.float32)
    finals = []
    for d in range(2):
        lam_bar, b_bar = ssm_discretize(p['lam_re'][d], p['lam_im'][d], p['log_dt'][d],
                                        p['b_re'][d], p['b_im'][d])
        h = ssm_scan(ug, lam_bar, b_bar, h0[:, d], reverse=(d == 1))
        cmat = lax.complex(p['c_re'][d].astype(jnp.float32), p['c_im'][d].astype(jnp.float32))
        y = y + jnp.real(jnp.einsum('gcp,btgp->btgc', cmat, h)).reshape(bsz, T, D_SSM)
        finals.append(h[:, -1] if d == 0 else h[:, 0])
    hf = jnp.stack(finals, axis=1)
    z = jax.nn.gelu(y).astype(u.dtype)
    z = z * jax.nn.sigmoid(z @ p['w_glu'])
    return z, jnp.real(hf), jnp.imag(hf)


def sink_column(sink, s):
    sk = sink.astype(jnp.float32).reshape(N_KV_HEADS, Q_PER_KV, 1, 1)
    return jnp.broadcast_to(sk, s.shape[:-1] + (1,))


def attention_context(q, k, v, sink):
    bsz, S = q.shape[:2]
    nqb = S // BLOCK
    qb = jnp.moveaxis(q.reshape(bsz, nqb, BLOCK, N_KV_HEADS, Q_PER_KV, HEAD_DIM), 1, 0)

    def one_block(qblk):
        s = jnp.einsum('bqkgd,bskd->bkgqs', qblk, k).astype(jnp.float32)
        pr = jax.nn.softmax(jnp.concatenate([s, sink_column(sink, s)], axis=-1), axis=-1)[..., :-1]
        return jnp.einsum('bkgqs,bskd->bqkgd', pr.astype(v.dtype), v)

    o = lax.map(one_block, qb)
    return jnp.moveaxis(o, 0, 1).reshape(bsz, S, D_ATTN)


def attention_latent(q, k, v, ck, cv, sink):
    bsz, T = q.shape[:2]
    nb = T // BLOCK
    pad = ((0, 0), (BLOCK, BLOCK), (0, 0), (0, 0))
    kp = jnp.pad(k, pad)
    vp = jnp.pad(v, pad)
    ar_q = jnp.arange(BLOCK)
    ar_k = jnp.arange(3 * BLOCK)

    def one_block(bi):
        start = bi * BLOCK
        qblk = lax.dynamic_slice_in_dim(q, start, BLOCK, axis=1)
        kblk = lax.dynamic_slice_in_dim(kp, start, 3 * BLOCK, axis=1)
        vblk = lax.dynamic_slice_in_dim(vp, start, 3 * BLOCK, axis=1)
        qpos = start + ar_q
        kpos = start - BLOCK + ar_k
        valid = ((jnp.abs(qpos[:, None] - kpos[None, :]) <= WINDOW)
                 & (kpos >= 0)[None, :] & (kpos < T)[None, :])
        s_loc = jnp.einsum('bqkgd,bskd->bkgqs', qblk, kblk).astype(jnp.float32)
        s_loc = jnp.where(valid, s_loc, NEG_INF)
        s_ctx = jnp.einsum('bqkgd,bskd->bkgqs', qblk, ck).astype(jnp.float32)
        pr = jax.nn.softmax(jnp.concatenate([s_loc, s_ctx, sink_column(sink, s_loc)], axis=-1), axis=-1)
        p_loc = pr[..., :3 * BLOCK].astype(v.dtype)
        p_ctx = pr[..., 3 * BLOCK:-1].astype(v.dtype)
        return (jnp.einsum('bkgqs,bskd->bqkgd', p_loc, vblk)
                + jnp.einsum('bkgqs,bskd->bqkgd', p_ctx, cv))

    o = lax.map(one_block, jnp.arange(nb))
    return jnp.moveaxis(o, 0, 1).reshape(bsz, T, D_ATTN)


def mixer(xm, p, h0_re, h0_im, rope, ctx_kv):
    bsz, T, _ = xm.shape
    proj = xm @ p['w_in']
    o1 = D_SSM
    o2 = o1 + D_ATTN
    o3 = o2 + D_KV
    o4 = o3 + D_KV
    o5 = o4 + D_MODEL
    u, q, k, v, g_s, g_a = jnp.split(proj, [o1, o2, o3, o4, o5], axis=-1)
    y_ssm, h_re, h_im = ssm_branch(u, p, h0_re, h0_im)
    q = q.reshape(bsz, T, N_KV_HEADS, Q_PER_KV, HEAD_DIM)
    k = k.reshape(bsz, T, N_KV_HEADS, HEAD_DIM)
    v = v.reshape(bsz, T, N_KV_HEADS, HEAD_DIM)
    if rope is not None:
        q = apply_axial_rope(q, rope)
        k = apply_axial_rope(k, rope)
    q = q * (HEAD_DIM ** -0.5)
    if ctx_kv is None:
        o = attention_context(q, k, v, p['sink'])
    else:
        o = attention_latent(q, k, v, ctx_kv[0], ctx_kv[1], p['sink'])
    merged = jax.nn.sigmoid(g_s) * (y_ssm @ p['w_ssm_o']) + jax.nn.sigmoid(g_a) * (o @ p['w_attn_o'])
    return merged @ p['w_out'], k, v, h_re, h_im


def conv_ffn(xm, p):
    h = xm @ p['w_up']
    T = h.shape[1]
    hp = jnp.pad(h, ((0, 0), (1, 1), (0, 0)))
    w = p['conv_w']
    h = hp[:, :T] * w[0] + hp[:, 1:T + 1] * w[1] + hp[:, 2:] * w[2] + p['conv_b']
    a, b = jnp.split(h, 2, axis=-1)
    return (jax.nn.silu(a) * b) @ p['w_down']


def layer_forward(x, mod, p, h0_re, h0_im, rope, ctx_kv):
    sh1, sc1, g1, sh2, sc2, g2 = mod
    xm = rmsnorm(x, p['norm_mix_g']) * (1.0 + sc1) + sh1
    out, k, v, h_re, h_im = mixer(xm, p, h0_re, h0_im, rope, ctx_kv)
    x = x + g1 * out
    xm2 = rmsnorm(x, p['norm_ffn_g']) * (1.0 + sc2) + sh2
    x = x + g2 * conv_ffn(xm2, p)
    return x, k, v, h_re, h_im


def setup_inputs(seed: int = 0) -> dict:
    key = jax.random.key(seed)
    ks = jax.random.split(key, 32)
    nrm = jax.random.normal
    f32 = jnp.float32
    L = DEPTH
    lam_im_base = math.pi * jnp.arange(SSM_STATE, dtype=f32)
    return {
        'x_prompt': nrm(ks[0], (BATCH, SEQ, D_MODEL), f32),
        'x_sample': nrm(ks[1], (DEC_BATCH, DEC_SEQ, D_MODEL), f32),
        'cache_k': nrm(ks[2], (DEC_BATCH, L, PAST_LEN, N_KV_HEADS, HEAD_DIM), f32),
        'cache_v': nrm(ks[3], (DEC_BATCH, L, PAST_LEN, N_KV_HEADS, HEAD_DIM), f32),
        'state_ssm_re': 0.1 * nrm(ks[4], (DEC_BATCH, L, 2, SSM_GROUPS, SSM_STATE), f32),
        'state_ssm_im': 0.1 * nrm(ks[5], (DEC_BATCH, L, 2, SSM_GROUPS, SSM_STATE), f32),
        'c': nrm(ks[6], (DEC_BATCH, D_MODEL), f32),
        'c_ctx': nrm(ks[7], (D_MODEL,), f32),
        'norm_mix_g': 1.0 + 0.01 * nrm(ks[8], (L, D_MODEL), f32),
        'norm_ffn_g': 1.0 + 0.01 * nrm(ks[9], (L, D_MODEL), f32),
        'w_mod': 0.5 * D_MODEL ** -0.5 * nrm(ks[10], (L, D_MODEL, 6 * D_MODEL), f32),
        'b_mod': 0.01 * nrm(ks[11], (L, 6 * D_MODEL), f32),
        'w_in': D_MODEL ** -0.5 * nrm(ks[12], (L, D_MODEL, IN_COLS), f32),
        'ssm_lambda_re': -0.5 + 0.01 * nrm(ks[13], (L, 2, SSM_GROUPS, SSM_STATE), f32),
        'ssm_lambda_im': lam_im_base + 0.01 * nrm(ks[14], (L, 2, SSM_GROUPS, SSM_STATE), f32),
        'ssm_log_dt': jax.random.uniform(ks[15], (L, 2, SSM_GROUPS), f32,
                                         minval=math.log(1e-3), maxval=math.log(1e-1)),
        'ssm_b_re': (2 * SSM_CH) ** -0.5 * nrm(ks[16], (L, 2, SSM_GROUPS, SSM_STATE, SSM_CH), f32),
        'ssm_b_im': (2 * SSM_CH) ** -0.5 * nrm(ks[17], (L, 2, SSM_GROUPS, SSM_STATE, SSM_CH), f32),
        'ssm_c_re': SSM_STATE ** -0.5 * nrm(ks[18], (L, 2, SSM_GROUPS, SSM_CH, SSM_STATE), f32),
        'ssm_c_im': SSM_STATE ** -0.5 * nrm(ks[19], (L, 2, SSM_GROUPS, SSM_CH, SSM_STATE), f32),
        'ssm_d': nrm(ks[20], (L, D_SSM), f32),
        'w_glu': D_SSM ** -0.5 * nrm(ks[21], (L, D_SSM, D_SSM), f32),
        'attn_sink': 0.5 * nrm(ks[22], (L, N_HEADS), f32),
        'w_ssm_o': D_SSM ** -0.5 * nrm(ks[23], (L, D_SSM, D_MODEL), f32),
        'w_attn_o': D_ATTN ** -0.5 * nrm(ks[24], (L, D_ATTN, D_MODEL), f32),
        'w_out': D_MODEL ** -0.5 * nrm(ks[25], (L, D_MODEL, D_MODEL), f32),
        'w_up': D_MODEL ** -0.5 * nrm(ks[26], (L, D_MODEL, 2 * D_FF), f32),
        'conv_w': CONV_WIDTH ** -0.5 * nrm(ks[27], (L, CONV_WIDTH, 2 * D_FF), f32),
        'conv_b': 0.01 * nrm(ks[28], (L, 2 * D_FF), f32),
        'w_down': D_FF ** -0.5 * nrm(ks[29], (L, D_FF, D_MODEL), f32),
        'final_norm_g': 1.0 + 0.01 * nrm(ks[30], (D_MODEL,), f32),
    }


def reference(x_prompt, x_sample, cache_k, cache_v, state_ssm_re, state_ssm_im, c, c_ctx,
              norm_mix_g, norm_ffn_g, w_mod, b_mod, w_in, ssm_lambda_re, ssm_lambda_im,
              ssm_log_dt, ssm_b_re, ssm_b_im, ssm_c_re, ssm_c_im, ssm_d, w_glu, attn_sink,
              w_ssm_o, w_attn_o, w_out, w_up, conv_w, conv_b, w_down, final_norm_g):
    rope = axial_rope_tables(x_sample.shape[1])
    zero_h = jnp.zeros((x_prompt.shape[0], 2, SSM_GROUPS, SSM_STATE), jnp.float32)
    xp = x_prompt
    xs = x_sample
    ks_out, vs_out, hre_out, him_out = [], [], [], []
    for l in range(DEPTH):
        p = {
            'norm_mix_g': norm_mix_g[l], 'norm_ffn_g': norm_ffn_g[l], 'w_in': w_in[l],
            'lam_re': ssm_lambda_re[l], 'lam_im': ssm_lambda_im[l], 'log_dt': ssm_log_dt[l],
            'b_re': ssm_b_re[l], 'b_im': ssm_b_im[l], 'c_re': ssm_c_re[l], 'c_im': ssm_c_im[l],
            'ssm_d': ssm_d[l], 'w_glu': w_glu[l], 'sink': attn_sink[l],
            'w_ssm_o': w_ssm_o[l], 'w_attn_o': w_attn_o[l], 'w_out': w_out[l],
            'w_up': w_up[l], 'conv_w': conv_w[l], 'conv_b': conv_b[l], 'w_down': w_down[l],
        }
        mod_ctx = adaln(c_ctx, w_mod[l], b_mod[l])
        xp, k_l, v_l, h_re, h_im = layer_forward(xp, mod_ctx, p, zero_h, zero_h, None, None)
        ks_out.append(k_l)
        vs_out.append(v_l)
        hre_out.append(h_re)
        him_out.append(h_im)
        mod_lat = adaln(c, w_mod[l], b_mod[l])
        xs, _, _, _, _ = layer_forward(xs, mod_lat, p, state_ssm_re[:, l], state_ssm_im[:, l], rope,
                                       (cache_k[:, l], cache_v[:, l]))
    y_prompt = rmsnorm(xp, final_norm_g)
    y_sample = rmsnorm(xs, final_norm_g)
    new_cache_k = jnp.stack(ks_out, axis=1)
    new_cache_v = jnp.stack(vs_out, axis=1)
    new_state_ssm_re = jnp.stack(hre_out, axis=1)
    new_state_ssm_im = jnp.stack(him_out, axis=1)
    return (y_prompt, y_sample, new_cache_k, new_cache_v, new_state_ssm_re, new_state_ssm_im)
```

```cpp
#include <hip/hip_runtime.h>
#include <hip/hip_cooperative_groups.h>
#include <cstdio>
#include <cstdint>
namespace cg = cooperative_groups;

#ifndef P1_REP
#define P1_REP 1
#endif
#ifndef MK_ONE_LAUNCH
#define MK_ONE_LAUNCH 1
#endif

#define LAS __attribute__((address_space(3)))
typedef unsigned short bf16_t;
typedef short bf16x8 __attribute__((ext_vector_type(8)));
typedef float f32x4 __attribute__((ext_vector_type(4)));
typedef float f32x16 __attribute__((ext_vector_type(16)));
typedef unsigned u32x4 __attribute__((ext_vector_type(4)));
typedef unsigned u32x2 __attribute__((ext_vector_type(2)));

constexpr int DM = 2048, NPROMPT = 8192, MT = 10240, INC = 6656, DFF = 5632, NUP = 11264;
constexpr float EPS = 1e-6f;
constexpr float LOG2E = 1.4426950408889634f;
constexpr float QSCALE = 0.08838834764831845f * LOG2E;
constexpr int NPH = 10;
constexpr int LDWUP = 2112;

constexpr size_t MiB = 1u << 20;
constexpr size_t WS_MOD = 0;
constexpr size_t WS_SHV2 = 147456;
constexpr size_t WS_RS1 = 282624;
constexpr size_t WS_RS2 = 323584;
constexpr size_t WS_BAR = 393216;
constexpr size_t WS_SPCNT = 417792;
constexpr size_t WS_QCTR = 409600;
constexpr size_t WS_PCNT = 425984;
constexpr size_t ZERO_BYTES = 512 * 1024;
constexpr size_t WS_G2 = 1 * MiB;
constexpr size_t WS_ROPEC = WS_G2 + 24576;
constexpr size_t WS_ROPES = WS_ROPEC + 8192;
constexpr size_t WS_CK = WS_G2 + 65536;
constexpr size_t WS_CV = WS_CK + 262144;
constexpr size_t WS_WIN = 8 * MiB;
constexpr size_t WS_WGLU = 34 * MiB;
constexpr size_t WS_WM = 36 * MiB;
constexpr size_t WS_WOUT = 44 * MiB;
constexpr size_t WS_WUP = 52 * MiB;
constexpr size_t WS_WDN = 368 * MiB;
constexpr size_t WS_XM = 118 * MiB;
constexpr size_t WS_Z = 118 * MiB;
constexpr size_t WS_U = 158 * MiB;
constexpr size_t WS_Q = 178 * MiB;
constexpr size_t WS_K = 198 * MiB;
constexpr size_t WS_V = 203 * MiB;
constexpr size_t WS_GS = 208 * MiB;
constexpr size_t WS_GA = 248 * MiB;
constexpr size_t WS_YF = 288 * MiB;
constexpr size_t WS_MERGED = 288 * MiB;
constexpr size_t WS_ZO = 328 * MiB;
constexpr size_t WS_ACT = 158 * MiB;
constexpr size_t WS_PART8 = 288 * MiB;
constexpr size_t WS_YBL = 368 * MiB;
constexpr size_t WS_HBP = 395 * MiB;
constexpr size_t WS_HBH = 396 * MiB;
constexpr size_t WS_YBP0 = 138 * MiB;
constexpr size_t WS_YBP1 = 378 * MiB;
constexpr size_t WS_XCH = 394 * MiB;
constexpr size_t WS_END = 397 * MiB;

constexpr int LDS_STAGE = 131072;
constexpr int LDS_EX = 131072;
constexpr int LDS_BYTES = 131072 + 16384 + 1024;

struct Args { const float* in[31]; float* out; unsigned char* ws; int ph_lo, ph_hi; };

typedef float f32x2_t __attribute__((ext_vector_type(2))); typedef __bf16 bf16x2_t __attribute__((ext_vector_type(2)));
__device__ __forceinline__ unsigned cvt_pk_bf16(float lo, float hi) { const f32x2_t v = {lo, hi}; const bf16x2_t b = __builtin_convertvector(v, bf16x2_t); return __builtin_bit_cast(unsigned, b); }
__device__ __forceinline__ float bf_lo(unsigned w) { return __uint_as_float(w << 16); }
__device__ __forceinline__ float bf_hi(unsigned w) { return __uint_as_float(w & 0xffff0000u); }
__device__ __forceinline__ f32x4 unpack4(u32x2 w) { return (f32x4){bf_lo(w.x), bf_hi(w.x), bf_lo(w.y), bf_hi(w.y)}; }
__device__ __forceinline__ u32x2 pack4(f32x4 v) { u32x2 w; w.x = cvt_pk_bf16(v[0], v[1]); w.y = cvt_pk_bf16(v[2], v[3]); return w; }
__device__ __forceinline__ float sigmoidf(float x) { return __builtin_amdgcn_rcpf(1.f + __expf(-x)); }
__device__ __forceinline__ f32x4 sigmoid4(f32x4 v) { return (f32x4){sigmoidf(v[0]), sigmoidf(v[1]), sigmoidf(v[2]), sigmoidf(v[3])}; }
__device__ __forceinline__ float wave_sum(float v) {
#pragma unroll
    for (int o = 1; o < 64; o <<= 1) v += __shfl_xor(v, o);
    return v;
}
__device__ __forceinline__ int crow(int r, int hi) { return (r & 3) + 8 * (r >> 2) + 4 * hi; }
__device__ __forceinline__ float dpp_ror1(float v) { return __builtin_bit_cast(float, __builtin_amdgcn_update_dpp(0, __builtin_bit_cast(int, v), 0x121, 0xf, 0xf, false)); }
__device__ __forceinline__ float dpp_ror15(float v) { return __builtin_bit_cast(float, __builtin_amdgcn_update_dpp(0, __builtin_bit_cast(int, v), 0x12F, 0xf, 0xf, false)); }
__device__ __forceinline__ void sincos_rr(float x, float& s, float& c) {
    const float n = rintf(x * 0.15915494309189535f);
    float r = fmaf(-n, 6.2831854820251465f, x); r = fmaf(-n, -1.7484556000744883e-07f, r);
    s = __sinf(r); c = __cosf(r);
}

namespace pg8 {
constexpr int BM = 256, BK = 64, HALF = 128, HTB = HALF * BK * 2, NXCD = 8, WGM = 3;
__host__ __device__ __forceinline__ int lds_byte(int r, int c) { const int st = (r >> 4) * 2 + (c >> 5), rr = r & 15, cc = c & 31, ob = rr * 64 + cc * 2; return st * 1024 + (ob ^ (((ob >> 9) & 1) << 5)); }
__host__ __device__ __forceinline__ void stage_rc(int b, int& R, int& C) { const int st = b / 1024, sb = b % 1024, swz = sb ^ (((sb >> 9) & 1) << 5); R = (st >> 1) * 16 + swz / 64; C = (st & 1) * 32 + (swz % 64) / 2; }
struct Unit { int pm, pn, k0, nk, sp, nsp, slot; };
struct Gemm { const bf16_t* A; const bf16_t* Bt; int lda, ldb; float* part; unsigned* cnt; };
struct StaticOrder {
    int nM, nN, nwg, G, c, nkt, rounds, R, nsp; bool qm;
    __device__ __forceinline__ void init(int nM_, int nN_, int G_, int c_, int nkt_, int max_sp) { nM = nM_; nN = nN_; nwg = nM * nN; G = G_; c = c_; nkt = nkt_; rounds = nwg / G; R = nwg - rounds * G; qm = false;
        nsp = 1; if (R > 0) { while (nsp * 2 * R <= G && nsp * 2 * R <= 256 && nsp * 2 <= max_sp && (nkt / (nsp * 2)) * (nsp * 2) == nkt && ((nkt / (nsp * 2)) & 1) == 0) nsp *= 2; } }
    __device__ __forceinline__ void map(int L, int& pm, int& pn) const {
        int wgid = L; { const int q = nwg / NXCD, r = nwg % NXCD, xcd = wgid % NXCD, off = wgid / NXCD; wgid = (xcd < r ? xcd * (q + 1) : r * (q + 1) + (xcd - r) * q) + off; }
        const int nig = WGM * nN, gid = wgid / nig, fm = gid * WGM, gsz = (nM - fm) < WGM ? (nM - fm) : WGM;
        pm = fm + ((wgid % nig) % gsz); pn = (wgid % nig) / gsz;
    }
    __device__ __forceinline__ bool next(int i, Unit& u) const {
        const bool quart = qm && R > 0 && R * 4 <= G;
        const int fan = quart ? 4 : nsp;
        const bool whole = i < rounds, part = (i == rounds) && (c < R * fan);
        const int j = c / fan, sub = part ? c - j * fan : 0, ns = (part && !quart) ? nsp : 1, nk = nkt / ns;
        int L = whole ? i * G + c : rounds * G + j; if (L >= nwg) L = nwg - 1;
        int pm, pn; map(L, pm, pn);
        u.pm = pm; u.pn = pn; u.k0 = quart ? 0 : sub * nk; u.nk = nk; u.sp = (part && quart) ? 1 + sub : (quart ? 0 : sub); u.nsp = ns; u.slot = (part && !quart) ? j : 0;
        return whole || part;
    }
};
template <class Epi, class Sched>
__device__ __forceinline__ void gemm_phase(LAS unsigned char* lds, const Gemm g, const Sched& S, const Epi& E) {
    const int tid = threadIdx.x, wid = __builtin_amdgcn_readfirstlane(tid >> 6), lane = tid & 63, wr = wid >> 2, wc = wid & 3, fr = lane & 15, fq = lane >> 4;
    unsigned voffA[2], voffB[2];
#pragma unroll
    for (int i = 0; i < 2; ++i) { int R, C; stage_rc(tid * 16 + i * 8192, R, C); voffA[i] = (unsigned)(R * g.lda + C) * 2u; voffB[i] = (unsigned)(R * g.ldb + C) * 2u; }
    const size_t kstep = (size_t)(BK * 2);
    const size_t hstepA = (size_t)HALF * g.lda * 2, hstepB = (size_t)HALF * g.ldb * 2;
    const unsigned ldsw = (unsigned)wid * 1024u;
    const int aoff = lds_byte(wr * 64 + fr, fq * 8), boff = lds_byte(wc * 32 + fr, fq * 8);
#define PG8_SA(b, h) (((b) * 2 + (h)) * HTB)
#define PG8_SB(b, h) ((4 + (b) * 2 + (h)) * HTB)
#define PG8_STAGE(bufoff, gbase, voff) do { _Pragma("unroll") for (int _i = 0; _i < 2; ++_i) \
        __builtin_amdgcn_global_load_lds((const unsigned*)((const char*)(gbase) + (voff)[_i]), (LAS unsigned*)(lds + (bufoff) + ldsw + _i * 8192), 16, 0, 0); } while (0)
#define PG8_LDA(dst, b, h) do { _Pragma("unroll") for (int m = 0; m < 4; ++m) _Pragma("unroll") for (int k = 0; k < 2; ++k) dst[m][k] = *(const LAS bf16x8*)(lds + PG8_SA(b, h) + aoff + m * 2048 + k * 1024); } while (0)
#define PG8_LDB(dst, b, h) do { _Pragma("unroll") for (int n = 0; n < 2; ++n) _Pragma("unroll") for (int k = 0; k < 2; ++k) dst[n][k] = *(const LAS bf16x8*)(lds + PG8_SB(b, h) + boff + n * 2048 + k * 1024); } while (0)
#define PG8_MMA(ai, bj, At, Bt) do { __builtin_amdgcn_s_setprio(1); _Pragma("unroll") for (int m = 0; m < 4; ++m) _Pragma("unroll") for (int n = 0; n < 2; ++n) _Pragma("unroll") for (int k = 0; k < 2; ++k) \
        acc[ai][bj][m][n] = __builtin_amdgcn_mfma_f32_16x16x32_bf16(Bt[n][k], At[m][k], acc[ai][bj][m][n], 0, 0, 0); __builtin_amdgcn_s_setprio(0); } while (0)
#define PG8_WAIT_V(n) asm volatile("s_waitcnt vmcnt(" #n ")" ::: "memory")
#define PG8_WAIT_L(n) asm volatile("s_waitcnt lgkmcnt(" #n ")" ::: "memory")
#define PG8_BAR __builtin_amdgcn_s_barrier()
#define PG8_SCHED __builtin_amdgcn_sched_barrier(0)
    Unit cur, nxt; int ui = 0;
    if (!S.next(0, cur)) return;
    f32x4 acc[2][2][4][2];
#pragma unroll
    for (int a = 0; a < 2; ++a)
#pragma unroll
        for (int b = 0; b < 2; ++b)
#pragma unroll
            for (int m = 0; m < 4; ++m)
#pragma unroll
                for (int n = 0; n < 2; ++n) acc[a][b][m][n] = (f32x4){0.f, 0.f, 0.f, 0.f};
    bf16x8 At[4][2], B0[2][2], B1[2][2];
    const char* cA = (const char*)g.A + E.aoff(cur, g.lda); const char* cB = (const char*)g.Bt + E.boff(cur, g.ldb);
    PG8_STAGE(PG8_SB(0, 0), cB, voffB); PG8_STAGE(PG8_SB(0, 1), cB + hstepB, voffB); PG8_STAGE(PG8_SA(0, 0), cA, voffA); PG8_STAGE(PG8_SA(0, 1), cA + hstepA, voffA);
    if (wr == 1) PG8_BAR;
    PG8_WAIT_V(2); PG8_BAR;
    PG8_STAGE(PG8_SB(1, 0), cB + kstep, voffB); PG8_STAGE(PG8_SA(1, 0), cA + kstep, voffA); PG8_STAGE(PG8_SB(1, 1), cB + hstepB + kstep, voffB);
    PG8_WAIT_V(6); PG8_BAR;
    for (;;) {
        const bool has_next = S.next(ui + 1, nxt);
        const char* nA = has_next ? (const char*)g.A + E.aoff(nxt, g.lda) : cA; const char* nB = has_next ? (const char*)g.Bt + E.boff(nxt, g.ldb) : cB;
        const int nt = cur.nk; const bool full = !(cur.nsp == 1 && cur.sp > 0);
        for (int t = 0; t < nt; t += 2) {
            const bool last = (t == nt - 2);
            const char* a1 = cA + (size_t)(t + 1) * kstep;
            const char* a2 = last ? nA : cA + (size_t)(t + 2) * kstep; const char* b2 = last ? nB : cB + (size_t)(t + 2) * kstep;
            const char* a3 = a2 + kstep; const char* b3 = b2 + kstep;
            PG8_LDB(B0, 0, 0); PG8_LDB(B1, 0, 1); PG8_SCHED; PG8_LDA(At, 0, 0); PG8_STAGE(PG8_SA(1, 1), a1 + hstepA, voffA);
            PG8_WAIT_V(8); PG8_WAIT_L(0); PG8_BAR; PG8_MMA(0, 0, At, B0); if (full) { PG8_MMA(0, 1, At, B1); } PG8_BAR; PG8_SCHED;
            PG8_LDA(At, 0, 1); PG8_STAGE(PG8_SB(0, 0), b2, voffB); PG8_STAGE(PG8_SB(0, 1), b2 + hstepB, voffB); PG8_STAGE(PG8_SA(0, 0), a2, voffA);
            PG8_WAIT_V(8); PG8_WAIT_L(0); PG8_BAR; if (full) { PG8_MMA(1, 0, At, B0); PG8_MMA(1, 1, At, B1); } PG8_BAR; PG8_SCHED;
            PG8_LDB(B0, 1, 0); PG8_LDB(B1, 1, 1); PG8_SCHED; PG8_LDA(At, 1, 0); PG8_STAGE(PG8_SA(0, 1), a2 + hstepA, voffA);
            PG8_WAIT_V(8); PG8_WAIT_L(0); PG8_BAR; PG8_MMA(0, 0, At, B0); if (full) { PG8_MMA(0, 1, At, B1); } PG8_BAR; PG8_SCHED;
            PG8_LDA(At, 1, 1); PG8_STAGE(PG8_SB(1, 0), b3, voffB); PG8_STAGE(PG8_SB(1, 1), b3 + hstepB, voffB); PG8_STAGE(PG8_SA(1, 0), a3, voffA);
            PG8_WAIT_V(8); PG8_WAIT_L(0); PG8_BAR; if (full) { PG8_MMA(1, 0, At, B0); PG8_MMA(1, 1, At, B1); } PG8_BAR; PG8_SCHED;
        }
        if (wr == 0) PG8_BAR;
        bool do_epi = true;
        if (cur.nsp > 1) {
            E.prescale(acc, cur, wr, wc, fr, fq);
            typedef float f32x2 __attribute__((ext_vector_type(2)));
            f32x4* pb16 = (f32x4*)g.part + (size_t)(cur.slot * cur.nsp) * 16384 + tid;
            { unsigned long long* pw = (unsigned long long*)(pb16 + (size_t)cur.sp * 16384);
#pragma unroll
              for (int a = 0; a < 2; ++a)
#pragma unroll
                for (int b = 0; b < 2; ++b)
#pragma unroll
                    for (int m = 0; m < 4; ++m)
#pragma unroll
                        for (int n = 0; n < 2; ++n) { const int i = ((a * 2 + b) * 4 + m) * 2 + n; const f32x4 v = acc[a][b][m][n];
                            __hip_atomic_store(pw + (size_t)i * 1024, __builtin_bit_cast(unsigned long long, (f32x2){v[0], v[1]}), __ATOMIC_RELAXED, __HIP_MEMORY_SCOPE_AGENT);
                            __hip_atomic_store(pw + (size_t)i * 1024 + 1, __builtin_bit_cast(unsigned long long, (f32x2){v[2], v[3]}), __ATOMIC_RELAXED, __HIP_MEMORY_SCOPE_AGENT); } }
            asm volatile("s_waitcnt vmcnt(0)" ::: "memory");
            __syncthreads();
            volatile LAS unsigned* fl = (volatile LAS unsigned*)(lds + LDS_EX + 16384 + 32);
            if (tid == 0) { const unsigned old = __hip_atomic_fetch_add(g.cnt + cur.slot, 1u, __ATOMIC_RELAXED, __HIP_MEMORY_SCOPE_AGENT);
                if (old == (unsigned)(cur.nsp - 1)) { __builtin_amdgcn_fence(__ATOMIC_ACQUIRE, "agent"); asm volatile("s_waitcnt vmcnt(0)" ::: "memory"); }
                fl[0] = old; }
            __syncthreads();
            do_epi = fl[0] == (unsigned)(cur.nsp - 1);
            if (do_epi) {
#pragma unroll
                for (int a = 0; a < 2; ++a)
#pragma unroll
                    for (int b = 0; b < 2; ++b)
#pragma unroll
                        for (int m = 0; m < 4; ++m)
#pragma unroll
                            for (int n = 0; n < 2; ++n) acc[a][b][m][n] = (f32x4){0.f, 0.f, 0.f, 0.f};
                for (int s = 0; s < cur.nsp; ++s) { const f32x4* pr = (const f32x4*)pb16 + (size_t)s * 16384;
#pragma unroll
                    for (int a = 0; a < 2; ++a) { f32x4 tv[2][4][2];
#pragma unroll
                        for (int b = 0; b < 2; ++b)
#pragma unroll
                            for (int m = 0; m < 4; ++m)
#pragma unroll
                                for (int n = 0; n < 2; ++n) tv[b][m][n] = pr[(((a * 2 + b) * 4 + m) * 2 + n) * 512];
#pragma unroll
                        for (int b = 0; b < 2; ++b)
#pragma unroll
                            for (int m = 0; m < 4; ++m)
#pragma unroll
                                for (int n = 0; n < 2; ++n) acc[a][b][m][n] += tv[b][m][n];
                        asm volatile("" ::: "memory"); } }
            }
        }
        if (do_epi) E(acc, cur, wr, wc, fr, fq, lds, ui & 1);
        if (!has_next) break;
#pragma unroll
        for (int a = 0; a < 2; ++a)
#pragma unroll
            for (int b = 0; b < 2; ++b)
#pragma unroll
                for (int m = 0; m < 4; ++m)
#pragma unroll
                    for (int n = 0; n < 2; ++n) acc[a][b][m][n] = (f32x4){0.f, 0.f, 0.f, 0.f};
        cur = nxt; cA = nA; cB = nB; ++ui;
        if (wr == 1) PG8_BAR;
    }
    PG8_WAIT_V(0);
    PG8_BAR;
#undef PG8_SA
#undef PG8_SB
#undef PG8_STAGE
#undef PG8_LDA
#undef PG8_LDB
#undef PG8_MMA
#undef PG8_WAIT_V
#undef PG8_WAIT_L
#undef PG8_BAR
#undef PG8_SCHED
}
}
using pg8::Unit;
#define EPI_FENCE() asm volatile("" ::: "memory")

struct EpiWin {
    bf16_t *U, *Q, *Kb, *Vb, *GS, *GA; float *outk, *outv; const float *ropec, *ropes;
    __device__ __forceinline__ int arow(int pm) const { return pm * 256; }
    __device__ __forceinline__ size_t aoff(const Unit& u, int lda) const { return (size_t)arow(u.pm) * lda * 2 + (size_t)u.k0 * 128; }
    __device__ __forceinline__ size_t boff(const Unit& u, int ldb) const { return (size_t)u.pn * 256 * ldb * 2 + (size_t)u.k0 * 128; }
    __device__ __forceinline__ void prescale(f32x4 (&acc)[2][2][4][2], const Unit& u, int wr, int wc, int fr, int fq) const {}
    __device__ __forceinline__ void operator()(f32x4 (&acc)[2][2][4][2], const Unit& u, int wr, int wc, int fr, int fq, LAS unsigned char* lds, int par) const {
        const int pn = u.pn; const int rowb = u.pm * 256 + wr * 64 + fr;
        if (pn < 4 || pn >= 10) {
            bf16_t* dst; int ld, cb; bool sig;
            if (pn < 4) { dst = U; ld = 1024; cb = pn * 256; sig = false; }
            else if (pn < 18) { dst = GS; ld = 2048; cb = (pn - 10) * 256; sig = true; }
            else { dst = GA; ld = 2048; cb = (pn - 18) * 256; sig = true; }
#pragma unroll
            for (int ai = 0; ai < 2; ++ai)
#pragma unroll
                for (int m = 0; m < 4; ++m) { bf16_t* rp = dst + (size_t)(rowb + 128 * ai + 16 * m) * ld + cb + 32 * wc + 4 * fq;
#pragma unroll
                    for (int bj = 0; bj < 2; ++bj)
#pragma unroll
                        for (int n = 0; n < 2; ++n) { f32x4 v = acc[ai][bj][m][n]; if (sig) v = sigmoid4(v); *(u32x2*)(rp + 128 * bj + 16 * n) = pack4(v); } }
        } else if (pn == 9) {
            const bool prm = u.pm < 32;
#pragma unroll
            for (int ai = 0; ai < 2; ++ai)
#pragma unroll
                for (int m = 0; m < 4; ++m) { const size_t off = (size_t)(rowb + 128 * ai + 16 * m) * 256 + 32 * wc + 4 * fq;
#pragma unroll
                    for (int bj = 0; bj < 2; ++bj)
#pragma unroll
                        for (int n = 0; n < 2; ++n) { const f32x4 v = acc[ai][bj][m][n]; *(u32x2*)(Vb + off + 128 * bj + 16 * n) = pack4(v); if (prm) *(f32x4*)(outv + off + 128 * bj + 16 * n) = v; } }
        } else {
            const bool isq = pn < 8, lat = u.pm >= 32; const int half = wc >> 1, f0 = (wc & 1) * 16 + 4 * fq, d1 = half * 64 + f0;
#pragma unroll
            for (int ai = 0; ai < 2; ++ai)
#pragma unroll
                for (int m = 0; m < 4; ++m) { const int row = rowb + 128 * ai + 16 * m;
                    f32x4 cs = (f32x4){1.f, 1.f, 1.f, 1.f}, sn = (f32x4){0.f, 0.f, 0.f, 0.f};
                    if (lat) { const int tl = (row - NPROMPT) & 1023; const int pr = half ? (tl & 63) : (tl >> 6); cs = *(const f32x4*)(ropec + pr * 32 + f0); sn = *(const f32x4*)(ropes + pr * 32 + f0); }
#pragma unroll
                    for (int bj = 0; bj < 2; ++bj) { const f32x4 x1 = acc[ai][bj][m][0], x2 = acc[ai][bj][m][1];
                        f32x4 o1 = x1 * cs - x2 * sn, o2 = x1 * sn + x2 * cs;
                        if (isq) { o1 = o1 * QSCALE; o2 = o2 * QSCALE; bf16_t* qp = Q + (size_t)row * 1024 + (pn - 4) * 256 + bj * 128 + d1; *(u32x2*)qp = pack4(o1); *(u32x2*)(qp + 32) = pack4(o2); }
                        else { const size_t off = (size_t)row * 256 + bj * 128 + d1; *(u32x2*)(Kb + off) = pack4(o1); *(u32x2*)(Kb + off + 32) = pack4(o2);
                            if (!lat) { *(f32x4*)(outk + off) = o1; *(f32x4*)(outk + off + 32) = o2; } } } }
        }
    }
};
struct WinOrder {
    int G, c;
    __device__ __forceinline__ bool next(int i, Unit& u) const {
        const int nwg = 1024; int L = i * G + c; const bool ok = L < nwg; if (!ok) L = nwg - 1;
        int wgid = L; { const int q = nwg / 8, xcd = wgid % 8, off = wgid / 8; wgid = xcd * q + off; }
        int pm, pn;
        if (wgid < 988) { constexpr int GW = 2; const int nig = GW * 26, gid = wgid / nig, fm = gid * GW, gsz = (38 - fm) < GW ? (38 - fm) : GW; pm = fm + ((wgid % nig) % gsz); pn = (wgid % nig) / gsz; }
        else { const int r = wgid - 988; pm = 38 + r / 18; pn = r % 18; }
        u.pm = pm; u.pn = pn; u.k0 = 0; u.nk = 32; u.sp = 0; u.nsp = 1; u.slot = 0; return ok;
    }
};
struct OneUnit {
    int pm, pn, nk;
    __device__ __forceinline__ bool next(int i, Unit& u) const { u.pm = pm; u.pn = pn; u.k0 = 0; u.nk = nk; u.sp = 0; u.nsp = 1; u.slot = 0; return i == 0; }
};
__device__ __forceinline__ void win_unit(LAS unsigned char* lds, const pg8::Gemm& g, const EpiWin& E, int t) { OneUnit S1; S1.pm = 38 + (t >> 3); S1.pn = 18 + (t & 7); S1.nk = 32; pg8::gemm_phase(lds, g, S1, E); }
struct EpiGlu {
    const bf16_t* Z; bf16_t* ZO;
    __device__ __forceinline__ int arow(int pm) const { return pm * 256; }
    __device__ __forceinline__ size_t aoff(const Unit& u, int lda) const { return (size_t)arow(u.pm) * lda * 2 + (size_t)u.k0 * 128; }
    __device__ __forceinline__ size_t boff(const Unit& u, int ldb) const { return (size_t)u.pn * 256 * ldb * 2 + (size_t)u.k0 * 128; }
    __device__ __forceinline__ void prescale(f32x4 (&acc)[2][2][4][2], const Unit& u, int wr, int wc, int fr, int fq) const {}
    __device__ __forceinline__ void operator()(f32x4 (&acc)[2][2][4][2], const Unit& u, int wr, int wc, int fr, int fq, LAS unsigned char* lds, int par) const {
        const int rowb = u.pm * 256 + wr * 64 + fr, cb = u.pn * 256 + 32 * wc + 4 * fq;
#pragma unroll
        for (int ai = 0; ai < 2; ++ai)
#pragma unroll
            for (int m = 0; m < 4; ++m) { const int row = rowb + 128 * ai + 16 * m;
#pragma unroll
                for (int bj = 0; bj < 2; ++bj)
#pragma unroll
                    for (int n = 0; n < 2; ++n) { const int col = cb + 128 * bj + 16 * n; const f32x4 z = unpack4(*(const u32x2*)(Z + (size_t)row * 1024 + col));
                        *(u32x2*)(ZO + (size_t)row * 2048 + col) = pack4(z * sigmoid4(acc[ai][bj][m][n])); }
                EPI_FENCE(); }
    }
};
struct EpiMerged {
    const bf16_t *GS, *GA; bf16_t* MG;
    __device__ __forceinline__ size_t aoff(const Unit& u, int lda) const { return ((size_t)u.pm * 256 + (u.sp > 0 ? ((u.sp - 1) >> 1) * 128 : 0)) * lda * 2 + (size_t)u.k0 * 128; }
    __device__ __forceinline__ size_t boff(const Unit& u, int ldb) const { return ((size_t)(u.pn >> 1) * 256 + (u.sp > 0 ? ((u.sp - 1) & 1) * 128 : 0)) * ldb * 2 + (size_t)u.k0 * 128; }
    __device__ __forceinline__ void prescale(f32x4 (&acc)[2][2][4][2], const Unit& u, int wr, int wc, int fr, int fq) const {}
    __device__ __forceinline__ void operator()(f32x4 (&acc)[2][2][4][2], const Unit& u, int wr, int wc, int fr, int fq, LAS unsigned char* lds, int par) const {
        const int seg = u.pn & 1; const bool quart = u.sp > 0; const int qr = quart ? ((u.sp - 1) >> 1) * 128 : 0, qc = quart ? ((u.sp - 1) & 1) * 128 : 0;
        const int rowb = u.pm * 256 + qr + wr * 64 + fr, cb = (u.pn >> 1) * 256 + qc + 32 * wc + 4 * fq; const bf16_t* gp = GS + (size_t)seg * (size_t)(20 * MiB);
#pragma unroll
        for (int ai = 0; ai < 2; ++ai)
#pragma unroll
            for (int m = 0; m < 4; ++m) { const size_t ro = (size_t)(rowb + 128 * ai + 16 * m) * 2048 + cb;
                if (quart && ai) continue;
#pragma unroll
                for (int bj = 0; bj < 2; ++bj) { if (quart && bj) continue;
#pragma unroll
                    for (int n = 0; n < 2; ++n) { f32x4 v = acc[ai][bj][m][n] * unpack4(*(const u32x2*)(gp + ro + 128 * bj + 16 * n));
                        if (seg) v += unpack4(*(const u32x2*)(MG + ro + 128 * bj + 16 * n));
                        *(u32x2*)(MG + ro + 128 * bj + 16 * n) = pack4(v); } }
                EPI_FENCE(); }
    }
};
static_assert(WS_GA - WS_GS == 40 * MiB, "EpiMerged addresses GA as GS + 20 Mi elements");
struct PairOrder {
    pg8::StaticOrder S;
    __device__ __forceinline__ bool next(int i, Unit& u) const {
        const int r2 = 2 * S.rounds; const bool whole = i < r2; const int i2 = i - r2;
        const bool quart = S.qm && S.R > 0 && S.R * 4 <= S.G; const int fan = quart ? 4 : 1;
        const bool part = !whole && i2 < 2 && S.c < S.R * fan;
        const int j = S.c / fan, q = S.c - j * fan; const int seg = (whole ? i : i2) & 1;
        int L = whole ? (i >> 1) * S.G + S.c : S.rounds * S.G + j; if (L >= S.nwg) L = S.nwg - 1;
        int pm, pn; S.map(L, pm, pn);
        u.pm = pm; u.pn = pn * 2 + seg; u.k0 = 16 * seg; u.nk = 16; u.sp = (part && quart) ? 1 + q : 0; u.nsp = 1; u.slot = 0;
        return whole || part;
    }
};
template <bool WRITE_XG> struct EpiRes {
    const float *xp, *xs; const float* xin; bool from_inputs; float* out; const float* mod; int gate_off; const float* G2; bf16_t* XG; float* rs; float* part;
    __device__ __forceinline__ int arow(int pm) const { return pm * 256; }
    __device__ __forceinline__ size_t aoff(const Unit& u, int lda) const { return ((size_t)arow(u.pm) + (u.sp > 0 ? ((u.sp - 1) >> 1) * 128 : 0)) * lda * 2 + (size_t)u.k0 * 128; }
    __device__ __forceinline__ size_t boff(const Unit& u, int ldb) const { return ((size_t)u.pn * 256 + (u.sp > 0 ? ((u.sp - 1) & 1) * 128 : 0)) * ldb * 2 + (size_t)u.k0 * 128; }
    __device__ __forceinline__ void prescale(f32x4 (&acc)[2][2][4][2], const Unit& u, int wr, int wc, int fr, int fq) const {}
    __device__ __forceinline__ void operator()(f32x4 (&acc)[2][2][4][2], const Unit& u, int wr, int wc, int fr, int fq, LAS unsigned char* lds, int par) const {
        const bool quart = u.sp > 0; const int qr = quart ? ((u.sp - 1) >> 1) * 128 : 0, qc = quart ? ((u.sp - 1) & 1) * 128 : 0;
        const int rowb = u.pm * 256 + qr + wr * 64 + fr, cb = u.pn * 256 + qc + 32 * wc + 4 * fq;
        const int ci = u.pm < 32 ? 0 : 1 + ((u.pm - 32) >> 2);
        const float* gp = mod + ci * 12288 + gate_off + cb; const float* g2p = G2 + ci * 2048 + cb;
        if (!WRITE_XG && u.slot > 0) {
            float* pp = part + (size_t)(u.slot - 1) * (2048 * 2048) + (size_t)(rowb - NPROMPT) * 2048 + cb;
#pragma unroll
            for (int ai = 0; ai < 2; ++ai)
#pragma unroll
                for (int m = 0; m < 4; ++m) {
#pragma unroll
                    for (int bj = 0; bj < 2; ++bj)
#pragma unroll
                        for (int n = 0; n < 2; ++n) *(f32x4*)(pp + (size_t)(128 * ai + 16 * m) * 2048 + 128 * bj + 16 * n) = acc[ai][bj][m][n] * *(const f32x4*)(gp + 128 * bj + 16 * n);
                    EPI_FENCE(); }
            return;
        }
        f32x4 gt[2][2], g2[2][2];
#pragma unroll
        for (int bj = 0; bj < 2; ++bj)
#pragma unroll
            for (int n = 0; n < 2; ++n) { gt[bj][n] = *(const f32x4*)(gp + 128 * bj + 16 * n); if (WRITE_XG) g2[bj][n] = *(const f32x4*)(g2p + 128 * bj + 16 * n); }
#pragma unroll
        for (int ai = 0; ai < 2; ++ai)
#pragma unroll
            for (int m = 0; m < 4; ++m) { const int row = rowb + 128 * ai + 16 * m; const size_t ro = (size_t)row * 2048 + cb;
                if (quart && ai) continue;
                const float* xr = from_inputs ? (row < NPROMPT ? xp + ro : xs + (ro - (size_t)NPROMPT * 2048)) : xin + ro;
                float ss = 0.f;
#pragma unroll
                for (int bj = 0; bj < 2; ++bj)
#pragma unroll
                    for (int n = 0; n < 2; ++n) { if (quart && bj) continue; const f32x4 xv = *(const f32x4*)(xr + 128 * bj + 16 * n); const f32x4 o = xv + gt[bj][n] * acc[ai][bj][m][n];
                        *(f32x4*)(out + ro + 128 * bj + 16 * n) = o; ss += (o[0] * o[0] + o[1] * o[1]) + (o[2] * o[2] + o[3] * o[3]);
                        if (WRITE_XG) *(u32x2*)(XG + ro + 128 * bj + 16 * n) = pack4(o * g2[bj][n]); }
                ss += __shfl_xor(ss, 16); ss += __shfl_xor(ss, 32);
                if (fq == 0) unsafeAtomicAdd(rs + row, ss);
                EPI_FENCE(); }
    }
};
struct EpiDown {
    float* out; const float* mod; float* rs; float* part; const float* fg; float* xch; unsigned* pcnt; bool fuse;
    __device__ __forceinline__ int arow(int pm) const { return pm * 256; }
    __device__ __forceinline__ size_t aoff(const Unit& u, int lda) const { return (size_t)arow(u.pm) * lda * 2 + (size_t)u.k0 * 128; }
    __device__ __forceinline__ size_t boff(const Unit& u, int ldb) const { return (size_t)u.pn * 256 * ldb * 2 + (size_t)u.k0 * 128; }
    __device__ __forceinline__ void prescale(f32x4 (&acc)[2][2][4][2], const Unit& u, int wr, int wc, int fr, int fq) const {}
    __device__ __forceinline__ void operator()(f32x4 (&acc)[2][2][4][2], const Unit& u, int wr, int wc, int fr, int fq, LAS unsigned char* lds, int par) const {
        const int tid = threadIdx.x;
        const int rowb = u.pm * 256 + wr * 64 + fr, cb = u.pn * 256 + 32 * wc + 4 * fq;
        const int ci = u.pm < 32 ? 0 : 1 + ((u.pm - 32) >> 2);
        const float* gp = mod + ci * 12288 + 5 * 2048 + cb;
        if (u.slot > 0) {
            float* pp = part + (size_t)(u.slot - 1) * (2048 * 2048) + (size_t)(rowb - NPROMPT) * 2048 + cb;
#pragma unroll
            for (int ai = 0; ai < 2; ++ai)
#pragma unroll
                for (int m = 0; m < 4; ++m) {
#pragma unroll
                    for (int bj = 0; bj < 2; ++bj)
#pragma unroll
                        for (int n = 0; n < 2; ++n) *(f32x4*)(pp + (size_t)(128 * ai + 16 * m) * 2048 + 128 * bj + 16 * n) = acc[ai][bj][m][n] * *(const f32x4*)(gp + 128 * bj + 16 * n);
                    EPI_FENCE(); }
            return;
        }
        float* ob = out + (size_t)u.pm * 256 * 2048 + u.pn * 256; const int lo_ = (wr * 64 + fr) * 2048 + 32 * wc + 4 * fq;
        f32x4 gt[2][2];
#pragma unroll
        for (int bj = 0; bj < 2; ++bj)
#pragma unroll
            for (int n = 0; n < 2; ++n) gt[bj][n] = *(const f32x4*)(gp + 128 * bj + 16 * n);
        float ssr[2][4];
#pragma unroll
        for (int ai = 0; ai < 2; ++ai)
#pragma unroll
            for (int m = 0; m < 4; ++m) { const int row = rowb + 128 * ai + 16 * m; const int ro = lo_ + (128 * ai + 16 * m) * 2048;
                float ss = 0.f;
#pragma unroll
                for (int bj = 0; bj < 2; ++bj)
#pragma unroll
                    for (int n = 0; n < 2; ++n) { const f32x4 xv = *(const f32x4*)(ob + (ro + 128 * bj + 16 * n)); const f32x4 o = xv + gt[bj][n] * acc[ai][bj][m][n];
                        ss += (o[0] * o[0] + o[1] * o[1]) + (o[2] * o[2] + o[3] * o[3]);
                        *(f32x4*)(ob + (ro + 128 * bj + 16 * n)) = o; }
                ss += __shfl_xor(ss, 16); ss += __shfl_xor(ss, 32);
                if (!fuse) { if (fq == 0) unsafeAtomicAdd(rs + row, ss); }
                ssr[ai][m] = ss;
                EPI_FENCE(); }
        if (!fuse) return;
        LAS float* P = (LAS float*)(lds + LDS_EX); LAS float* S = P + 1024; volatile LAS unsigned* fl = (volatile LAS unsigned*)(lds + LDS_EX + 8192);
#pragma unroll
        for (int ai = 0; ai < 2; ++ai)
#pragma unroll
            for (int m = 0; m < 4; ++m) if (fq == 0) P[(128 * ai + 64 * wr + 16 * m + fr) * 4 + wc] = ssr[ai][m];
        asm volatile("s_waitcnt lgkmcnt(0)" ::: "memory"); __syncthreads();
        if (tid < 256) { const float s = (P[tid * 4 + 0] + P[tid * 4 + 1]) + (P[tid * 4 + 2] + P[tid * 4 + 3]);
            __hip_atomic_store(xch + (size_t)(u.pm * 256 + tid) * 8 + u.pn, s, __ATOMIC_RELAXED, __HIP_MEMORY_SCOPE_AGENT); }
        asm volatile("s_waitcnt vmcnt(0)" ::: "memory"); __syncthreads();
        if (tid == 0) { unsigned* pc = pcnt + 64 * u.pm; __hip_atomic_fetch_add(pc, 1u, __ATOMIC_RELAXED, __HIP_MEMORY_SCOPE_AGENT);
            unsigned sp_ = 0; while (__hip_atomic_load(pc, __ATOMIC_RELAXED, __HIP_MEMORY_SCOPE_AGENT) < 8u) { __builtin_amdgcn_s_sleep(2); if (++sp_ > (1u << 22)) break; }
            __builtin_amdgcn_fence(__ATOMIC_ACQUIRE, "agent"); asm volatile("s_waitcnt vmcnt(0)" ::: "memory"); fl[0] = 1u; }
        __syncthreads();
        if (tid < 256) { const float* xr = xch + (size_t)(u.pm * 256 + tid) * 8; float tot = 0.f;
#pragma unroll
            for (int j = 0; j < 8; ++j) tot += __hip_atomic_load(xr + j, __ATOMIC_RELAXED, __HIP_MEMORY_SCOPE_AGENT);
            S[tid] = rsqrtf(tot * (1.f / DM) + EPS); }
        asm volatile("s_waitcnt lgkmcnt(0)" ::: "memory"); __syncthreads();
        f32x4 fgv[2][2];
#pragma unroll
        for (int bj = 0; bj < 2; ++bj)
#pragma unroll
            for (int n = 0; n < 2; ++n) fgv[bj][n] = *(const f32x4*)(fg + cb + 128 * bj + 16 * n);
#pragma unroll
        for (int ai = 0; ai < 2; ++ai)
#pragma unroll
            for (int m = 0; m < 4; ++m) { const int rl = 128 * ai + 64 * wr + 16 * m + fr; const float r = S[rl]; const int ro = lo_ + (128 * ai + 16 * m) * 2048;
#pragma unroll
                for (int bj = 0; bj < 2; ++bj)
#pragma unroll
                    for (int n = 0; n < 2; ++n) { const f32x4 x2 = *(const f32x4*)(ob + (ro + 128 * bj + 16 * n)); *(f32x4*)(ob + (ro + 128 * bj + 16 * n)) = x2 * r * fgv[bj][n]; }
                EPI_FENCE(); }
    }
};
struct DownOrder {
    pg8::StaticOrder S; bool split;
    __device__ __forceinline__ bool next(int i, Unit& u) const {
        if (!split) return S.next(i, u);
        const int c = S.c; const bool r0 = i == 0, ok = i < 2;
        const int j = c >> 2, sp = c & 3;
        u.pm = r0 ? (c >> 6) * 8 + (c & 7) : 32 + (j & 7); u.pn = r0 ? (c & 63) >> 3 : j >> 3;
        u.k0 = r0 ? 0 : sp * 22; u.nk = r0 ? 88 : 22; u.sp = 0; u.nsp = 1; u.slot = r0 ? 0 : 1 + sp;
        return ok;
    }
};
struct EpiUp {
    const float *rs1, *shv2, *convw, *convb; bf16_t* ACT; float *hbp, *hbh;
    __device__ __forceinline__ int arow(int pm) const { return pm * 256; }
    __device__ __forceinline__ size_t aoff(const Unit& u, int lda) const { return (size_t)arow(u.pm) * lda * 2 + (size_t)u.k0 * 128; }
    __device__ __forceinline__ size_t boff(const Unit& u, int ldb) const { return (size_t)u.pn * 256 * ldb * 2 + (size_t)u.k0 * 128; }
    __device__ __forceinline__ void prescale(f32x4 (&acc)[2][2][4][2], const Unit& u, int wr, int wc, int fr, int fq) const {}
    __device__ __forceinline__ void operator()(f32x4 (&acc)[2][2][4][2], const Unit& u, int wr, int wc, int fr, int fq, LAS unsigned char* lds, int par) const {
        const int pm = u.pm, pn = u.pn; const int ar = arow(pm);
        int seq_lo, seq_hi, ci; bool d0 = false, d255 = false;
        if (pm < 32) { seq_lo = ar; seq_hi = ar + 256; ci = 0; }
        else { const int lb = (pm - 32) >> 2, j = (pm - 32) & 3; seq_lo = NPROMPT + 1024 * lb; seq_hi = seq_lo + 1024; ci = 1 + lb; d0 = j != 0; d255 = j != 3; }
        const int st_lo = 0, st_hi = 255;
        const int jj0 = 32 * wc + 4 * fq;
        const int ca0 = 128 * pn + jj0;
        f32x4 sh[2][2];
#pragma unroll
        for (int bj = 0; bj < 2; ++bj)
#pragma unroll
            for (int n = 0; n < 2; ++n) sh[bj][n] = *(const f32x4*)(shv2 + ci * NUP + bj * DFF + ca0 + 16 * n);
#pragma unroll
        for (int ai = 0; ai < 2; ++ai)
#pragma unroll
            for (int m = 0; m < 4; ++m) { const int row = ar + 128 * ai + 64 * wr + 16 * m + fr; const bool ok = row >= seq_lo && row < seq_hi;
                const float rstd = ok ? rsqrtf(rs1[row] * (1.f / DM) + EPS) : 0.f;
#pragma unroll
                for (int bj = 0; bj < 2; ++bj)
#pragma unroll
                    for (int n = 0; n < 2; ++n) { f32x4 h = acc[ai][bj][m][n] * rstd + sh[bj][n]; if (!ok) h = (f32x4){0.f, 0.f, 0.f, 0.f}; acc[ai][bj][m][n] = h; } }
        LAS float* ex = (LAS float*)(lds + LDS_EX + par * 8192);
#pragma unroll
        for (int ai = 0; ai < 2; ++ai)
#pragma unroll
            for (int bj = 0; bj < 2; ++bj)
#pragma unroll
                for (int n = 0; n < 2; ++n) { const int colx = 128 * bj + jj0 + 16 * n;
                    if (fr == 0) *(LAS f32x4*)(ex + ((ai * 2 + wr) * 2 + 0) * 256 + colx) = acc[ai][bj][0][n];
                    if (fr == 15) *(LAS f32x4*)(ex + ((ai * 2 + wr) * 2 + 1) * 256 + colx) = acc[ai][bj][3][n]; }
        asm volatile("s_waitcnt lgkmcnt(0)" ::: "memory"); __builtin_amdgcn_s_barrier(); asm volatile("" ::: "memory");
#pragma unroll
        for (int n = 0; n < 2; ++n) {
            f32x4 w0[2], w1[2], w2[2], cbv[2];
#pragma unroll
            for (int bj = 0; bj < 2; ++bj) { const int oc = bj * DFF + ca0 + 16 * n; w0[bj] = *(const f32x4*)(convw + oc); w1[bj] = *(const f32x4*)(convw + NUP + oc); w2[bj] = *(const f32x4*)(convw + 2 * NUP + oc); cbv[bj] = *(const f32x4*)(convb + oc); }
#pragma unroll
            for (int ai = 0; ai < 2; ++ai) {
                const int sidx = ai * 2 + wr;
#pragma unroll
                for (int m = 0; m < 4; ++m) { const int il = 128 * ai + 64 * wr + 16 * m + fr; const int row = ar + il;
                    const bool st = il >= st_lo && il <= st_hi && row < seq_hi;
                    f32x4 cv[2];
#pragma unroll
                    for (int bj = 0; bj < 2; ++bj) { const int colx = 128 * bj + jj0 + 16 * n;
                        const f32x4 hc = acc[ai][bj][m][n]; f32x4 up, dn;
                        if (m > 0) { const f32x4 hp = acc[ai][bj][m > 0 ? m - 1 : 0][n];
#pragma unroll
                            for (int e = 0; e < 4; ++e) up[e] = dpp_ror1(fr == 15 ? hp[e] : hc[e]); }
                        else { f32x4 edge = (f32x4){0.f, 0.f, 0.f, 0.f}; if (sidx > 0) edge = *(const LAS f32x4*)(ex + ((sidx - 1) * 2 + 1) * 256 + colx);
#pragma unroll
                            for (int e = 0; e < 4; ++e) { const float a_ = dpp_ror1(hc[e]); up[e] = fr == 0 ? edge[e] : a_; } }
                        if (m < 3) { const f32x4 hn = acc[ai][bj][m < 3 ? m + 1 : 3][n];
#pragma unroll
                            for (int e = 0; e < 4; ++e) dn[e] = dpp_ror15(fr == 0 ? hn[e] : hc[e]); }
                        else { f32x4 edge = (f32x4){0.f, 0.f, 0.f, 0.f}; if (sidx < 3) edge = *(const LAS f32x4*)(ex + ((sidx + 1) * 2 + 0) * 256 + colx);
#pragma unroll
                            for (int e = 0; e < 4; ++e) { const float a_ = dpp_ror15(hc[e]); dn[e] = fr == 15 ? edge[e] : a_; } }
                        cv[bj] = up * w0[bj] + hc * w1[bj] + dn * w2[bj] + cbv[bj]; }
                    const bool def = (il == 0 && d0) || (il == 255 && d255);
                    if (st && !def) { const f32x4 a_ = cv[0], b_ = cv[1]; f32x4 o;
#pragma unroll
                        for (int e = 0; e < 4; ++e) o[e] = a_[e] * sigmoidf(a_[e]) * b_[e];
                        *(u32x2*)(ACT + (size_t)row * DFF + ca0 + 16 * n) = pack4(o); }
                    if (def) { const size_t hb = (size_t)((pm - 32) * 2 + (il == 255 ? 1 : 0)) * NUP + ca0 + 16 * n;
                        *(f32x4*)(hbp + hb) = cv[0]; *(f32x4*)(hbp + hb + DFF) = cv[1]; *(f32x4*)(hbh + hb) = acc[ai][0][m][n]; *(f32x4*)(hbh + hb + DFF) = acc[ai][1][m][n]; }
                    EPI_FENCE(); }
            }
        }
    }
};

__device__ __forceinline__ int rowmap_win(int n) { if (n >= 1024 && n < 2304) { const int d = n & 127; return (n & ~127) + 32 * (2 * (d >> 6) + ((d >> 4) & 1)) + 16 * ((d >> 5) & 1) + (d & 15); } return n; }
__device__ __forceinline__ int rowmap_up(int n) { return n < DFF ? ((n >> 7) * 256 + (n & 127)) : (((n - DFF) >> 7) * 256 + 128 + ((n - DFF) & 127)); }
template <int MODE> __device__ __forceinline__ void transpose_item(const float* W, int N, bf16_t* WT, int ldk, int koff, LAS float* scr, int item, int lane, const float* sh2, float* shv) {
    const int nblk = N / 32, kb = item / nblk, nb = item % nblk, k0 = 64 * kb, n0 = 32 * nb;
    { f32x4 tv[8]; const int r8 = lane >> 3, c4 = (lane & 7) * 4;
#pragma unroll
      for (int i = 0; i < 8; ++i) tv[i] = *(const f32x4*)(W + (size_t)(k0 + 8 * i + r8) * N + n0 + c4);
#pragma unroll
      for (int i = 0; i < 8; ++i) { LAS float* d = scr + (8 * i + r8) * 33 + c4; d[0] = tv[i][0]; d[1] = tv[i][1]; d[2] = tv[i][2]; d[3] = tv[i][3]; } }
    asm volatile("s_waitcnt lgkmcnt(0)" ::: "memory");
    const int c = lane & 7;
#pragma unroll
    for (int j = 0; j < 4; ++j) { const int n = (lane >> 3) + 8 * j; const LAS float* s = scr + (8 * c) * 33 + n;
        u32x4 o; o.x = cvt_pk_bf16(s[0 * 33], s[1 * 33]); o.y = cvt_pk_bf16(s[2 * 33], s[3 * 33]); o.z = cvt_pk_bf16(s[4 * 33], s[5 * 33]); o.w = cvt_pk_bf16(s[6 * 33], s[7 * 33]);
        const int ns = n0 + n; const int rdst = MODE == 1 ? rowmap_win(ns) : (MODE == 2 ? rowmap_up(ns) : ns);
        *(u32x4*)(WT + (size_t)rdst * ldk + koff + k0 + 8 * c) = o; }
    asm volatile("s_waitcnt lgkmcnt(0)" ::: "memory");
}
__device__ __forceinline__ void phase0(const Args& a, LAS unsigned char* lds) {
    const int tid = threadIdx.x;
    LAS float* sl = (LAS float*)lds;
    LAS float* red = (LAS float*)(lds + 24576);
    const float* c = a.in[6]; const float* cctx = a.in[7];
    for (int i = tid; i < 3 * 2048; i += 512) { const int ci = i >> 11, k = i & 2047; const float x = ci == 0 ? cctx[k] : c[(ci - 1) * 2048 + k]; sl[i] = x * sigmoidf(x); }
    __syncthreads();
    float* mod = (float*)(a.ws + WS_MOD); const float* wmod = a.in[10]; const float* bmod = a.in[11];
    const int cgp = tid & 127, rg = tid >> 7;
    for (int it = blockIdx.x; it < 768; it += gridDim.x) {
        const int nc = it % 24, ks = it / 24, n0 = nc * 512, k0 = ks * 64;
        f32x4 a0 = (f32x4){0.f, 0.f, 0.f, 0.f}, a1 = a0, a2 = a0;
        { f32x4 wv[16];
#pragma unroll
          for (int i = 0; i < 16; ++i) wv[i] = *(const f32x4*)(wmod + (size_t)(k0 + rg + 4 * i) * 12288 + n0 + 4 * cgp);
#pragma unroll
          for (int i = 0; i < 16; ++i) { const int k = k0 + rg + 4 * i; a0 += wv[i] * sl[k]; a1 += wv[i] * sl[2048 + k]; a2 += wv[i] * sl[4096 + k]; } }
        *(LAS f32x4*)(red + (rg * 3 + 0) * 512 + 4 * cgp) = a0; *(LAS f32x4*)(red + (rg * 3 + 1) * 512 + 4 * cgp) = a1; *(LAS f32x4*)(red + (rg * 3 + 2) * 512 + 4 * cgp) = a2;
        __syncthreads();
#pragma unroll
        for (int ci = 0; ci < 3; ++ci) { float v = (red[(0 * 3 + ci) * 512 + tid] + red[(1 * 3 + ci) * 512 + tid]) + (red[(2 * 3 + ci) * 512 + tid] + red[(3 * 3 + ci) * 512 + tid]);
            if (ks == 0) v += bmod[n0 + tid]; unsafeAtomicAdd(mod + ci * 12288 + n0 + tid, v); }
        __syncthreads();
    }
    if (blockIdx.x == gridDim.x - 1) {
        float* rc = (float*)(a.ws + WS_ROPEC); float* rsn = (float*)(a.ws + WS_ROPES);
        for (int i = tid; i < 2048; i += 512) { const int p = i >> 5, f = i & 31; const float inv = exp2f(-(float)f * (13.287712379549449f / 32.f)); float s, cc; sincos_rr((float)p * inv, s, cc); rc[i] = cc; rsn[i] = s; }
    }
    __syncthreads();
    { const int lane = tid & 63, wave = __builtin_amdgcn_readfirstlane(tid >> 6); LAS float* scr = (LAS float*)(lds + wave * 8704); const int gw = blockIdx.x * 8 + wave, NGW = gridDim.x * 8;
    constexpr int I_UP = 32 * 352, I_WIN = 32 * 208;
    for (int it = gw; it < I_WIN + I_UP; it += NGW) {
        if (it < I_WIN) transpose_item<1>(a.in[12], INC, (bf16_t*)(a.ws + WS_WIN), 2048, 0, scr, it, lane, nullptr, nullptr);
        else transpose_item<2>(a.in[26], NUP, (bf16_t*)(a.ws + WS_WUP), LDWUP, 0, scr, it - I_WIN, lane, nullptr, nullptr);
    }
      const int gt = blockIdx.x * 512 + tid, NGT = gridDim.x * 512;
    { bf16_t* CK = (bf16_t*)(a.ws + WS_CK); bf16_t* CV = (bf16_t*)(a.ws + WS_CV);
      for (int i = gt; i < 32768; i += NGT) { const f32x4 kv = *(const f32x4*)(a.in[2] + 4 * i), vv = *(const f32x4*)(a.in[3] + 4 * i); *(u32x2*)(CK + 4 * i) = pack4(kv); *(u32x2*)(CV + 4 * i) = pack4(vv); } }
    }
}

__device__ __forceinline__ void phase1(const Args& a, LAS unsigned char* lds) {
    const int tid = threadIdx.x, lane = tid & 63, wave = __builtin_amdgcn_readfirstlane(tid >> 6);
    LAS float* scr = (LAS float*)(lds + wave * 8704);
    const int gw = blockIdx.x * 8 + wave, NGW = gridDim.x * 8;
    const float* mod = (const float*)(a.ws + WS_MOD);
    const float* g1 = a.in[8]; bf16_t* XM = (bf16_t*)(a.ws + WS_XM);
    for (int m0 = gw; m0 < MT; m0 += 2 * NGW) {
        f32x4 v[2][8]; float ss[2] = {0.f, 0.f};
#pragma unroll
        for (int q = 0; q < 2; ++q) { const int m = (m0 + q * NGW) < MT ? (m0 + q * NGW) : m0; const float* xr = m < NPROMPT ? a.in[0] + (size_t)m * DM : a.in[1] + (size_t)(m - NPROMPT) * DM;
#pragma unroll
            for (int j = 0; j < 8; ++j) v[q][j] = *(const f32x4*)(xr + 4 * lane + 256 * j); }
#pragma unroll
        for (int q = 0; q < 2; ++q) { const int m = m0 + q * NGW; if (m >= MT) continue; const int ci = m < NPROMPT ? 0 : 1 + ((m - NPROMPT) >> 10);
#pragma unroll
            for (int j = 0; j < 8; ++j) ss[q] += (v[q][j][0] * v[q][j][0] + v[q][j][1] * v[q][j][1]) + (v[q][j][2] * v[q][j][2] + v[q][j][3] * v[q][j][3]);
            const float rstd = rsqrtf(wave_sum(ss[q]) * (1.f / DM) + EPS);
#pragma unroll
            for (int j = 0; j < 8; ++j) { const int col = 4 * lane + 256 * j; const f32x4 g = *(const f32x4*)(g1 + col), sc = *(const f32x4*)(mod + ci * 12288 + 2048 + col), sh = *(const f32x4*)(mod + ci * 12288 + col);
                const f32x4 o = v[q][j] * rstd * g * (sc + 1.f) + sh; *(u32x2*)(XM + (size_t)m * DM + col) = pack4(o); } }
    }
    const int gt = blockIdx.x * 512 + tid, NGT = gridDim.x * 512;
    { float* G2 = (float*)(a.ws + WS_G2); const float* g2n = a.in[9];
      for (int i = gt; i < 3 * 2048; i += NGT) { const int ci = i >> 11, col = i & 2047; G2[i] = g2n[col] * (1.f + mod[ci * 12288 + 4 * 2048 + col]); } }
}

__device__ __forceinline__ void drain_transposes(const Args& a, LAS unsigned char* lds, int kind, int lo, int hi, unsigned* ctr) {
    const int lane = threadIdx.x & 63, wave = __builtin_amdgcn_readfirstlane(threadIdx.x >> 6);
    LAS float* scr = (LAS float*)(lds + wave * 8704);
    const float* mod = (const float*)(a.ws + WS_MOD);
    for (;;) {
        int it = 0; if (lane == 0) it = (int)atomicAdd(ctr, 1u); it = __builtin_amdgcn_readfirstlane(it) + lo;
        if (it >= hi) break;
        if (kind == 1) transpose_item<2>(a.in[26], NUP, (bf16_t*)(a.ws + WS_WUP), LDWUP, 0, scr, it, lane, mod + 3 * 2048, (float*)(a.ws + WS_SHV2));
        else if (kind == 2) transpose_item<0>(a.in[29], 2048, (bf16_t*)(a.ws + WS_WDN), DFF, 0, scr, it, lane, nullptr, nullptr);
        else { int r = it;
            if (r < 512) transpose_item<0>(a.in[21], 1024, (bf16_t*)(a.ws + WS_WGLU), 1024, 0, scr, r, lane, nullptr, nullptr);
            else if (r < 1536) transpose_item<0>(a.in[23], 2048, (bf16_t*)(a.ws + WS_WM), 2048, 0, scr, r - 512, lane, nullptr, nullptr);
            else if (r < 2560) transpose_item<0>(a.in[24], 2048, (bf16_t*)(a.ws + WS_WM), 2048, 1024, scr, r - 1536, lane, nullptr, nullptr);
            else transpose_item<0>(a.in[25], 2048, (bf16_t*)(a.ws + WS_WOUT), 2048, 0, scr, r - 2560, lane, nullptr, nullptr); }
    }
}

__device__ __forceinline__ void shv2_rows(const Args& a) {
    const int lane = threadIdx.x & 63, wave = __builtin_amdgcn_readfirstlane(threadIdx.x >> 6);
    const float* mod = (const float*)(a.ws + WS_MOD); float* shv = (float*)(a.ws + WS_SHV2);
    f32x4 sv[3][4][2];
#pragma unroll
    for (int ci = 0; ci < 3; ++ci)
#pragma unroll
        for (int j = 0; j < 4; ++j) { const int k = 8 * lane + 512 * j; sv[ci][j][0] = *(const f32x4*)(mod + ci * 12288 + 3 * 2048 + k); sv[ci][j][1] = *(const f32x4*)(mod + ci * 12288 + 3 * 2048 + k + 4); }
    const int nw = gridDim.x * 8;
    for (int n0 = blockIdx.x * 8 + wave; n0 < NUP; n0 += 3 * nw) {
        u32x4 w[3][4];
#pragma unroll
        for (int q = 0; q < 3; ++q) { const int n = n0 + q * nw; const int nc = n < NUP ? n : n0;
            const bf16_t* wr_ = (const bf16_t*)(a.ws + WS_WUP) + (size_t)rowmap_up(nc) * LDWUP + 8 * lane;
#pragma unroll
            for (int j = 0; j < 4; ++j) w[q][j] = *(const u32x4*)(wr_ + 512 * j); }
#pragma unroll
        for (int q = 0; q < 3; ++q) { const int n = n0 + q * nw; float v[3] = {0.f, 0.f, 0.f};
#pragma unroll
            for (int j = 0; j < 4; ++j) { const f32x4 wa = unpack4((u32x2){w[q][j].x, w[q][j].y}), wb = unpack4((u32x2){w[q][j].z, w[q][j].w});
#pragma unroll
                for (int ci = 0; ci < 3; ++ci) { const f32x4 sa = sv[ci][j][0], sb = sv[ci][j][1];
                    v[ci] += (wa[0] * sa[0] + wa[1] * sa[1]) + (wa[2] * sa[2] + wa[3] * sa[3]) + (wb[0] * sb[0] + wb[1] * sb[1]) + (wb[2] * sb[2] + wb[3] * sb[3]); } }
            const float v0 = wave_sum(v[0]), v1 = wave_sum(v[1]), v2 = wave_sum(v[2]);
            if (lane == 0 && n < NUP) { shv[n] = v0; shv[NUP + n] = v1; shv[2 * NUP + n] = v2; } }
    }
}

__device__ __forceinline__ void small_weight_item(const Args& a, LAS float* scr, int it, int lane) {
    if (it < 512) transpose_item<0>(a.in[21], 1024, (bf16_t*)(a.ws + WS_WGLU), 1024, 0, scr, it, lane, nullptr, nullptr);
    else if (it < 1536) transpose_item<0>(a.in[23], 2048, (bf16_t*)(a.ws + WS_WM), 2048, 0, scr, it - 512, lane, nullptr, nullptr);
    else if (it < 2560) transpose_item<0>(a.in[24], 2048, (bf16_t*)(a.ws + WS_WM), 2048, 1024, scr, it - 1536, lane, nullptr, nullptr);
    else transpose_item<0>(a.in[25], 2048, (bf16_t*)(a.ws + WS_WOUT), 2048, 0, scr, it - 2560, lane, nullptr, nullptr);
}

__device__ __forceinline__ void attn_unit(const Args& a, LAS unsigned char* lds, int idx) {
    const int tid = threadIdx.x, lane = tid & 63, w = __builtin_amdgcn_readfirstlane(tid >> 6), n = lane & 31, hi = lane >> 5;
    const bf16_t* Q = (const bf16_t*)(a.ws + WS_Q); const bf16_t* Kb = (const bf16_t*)(a.ws + WS_K); const bf16_t* Vb = (const bf16_t*)(a.ws + WS_V);
    const bf16_t* CK = (const bf16_t*)(a.ws + WS_CK); const bf16_t* CV = (const bf16_t*)(a.ws + WS_CV); bf16_t* ZO = (bf16_t*)(a.ws + WS_ZO);
    LAS unsigned char* Ks = lds; LAS unsigned char* Vt = lds + 17408; LAS float* wsf = (LAS float*)(lds + 35840 + w * 256);
    bool lat; int rb, kvh, qb, hp, lb;
    if (idx < 64) { lat = true; lb = idx >> 5; const int rest = idx & 31; kvh = rest >> 4; qb = (rest >> 1) & 7; hp = rest & 1; rb = NPROMPT + lb * 1024; }
    else { lat = false; const int j = idx - 64; lb = j >> 3; kvh = (j >> 2) & 1; qb = (j >> 1) & 1; hp = j & 1; rb = lb * 256; }
    const int head = kvh * 4 + hp * 2 + (w >> 2);
    const int qloc = qb * 128 + (w & 3) * 32;
    bf16x8 qf[8];
    { const bf16_t* qp = Q + (size_t)(rb + qloc + n) * 1024 + head * 128 + 8 * hi;
#pragma unroll
      for (int s = 0; s < 8; ++s) qf[s] = *(const bf16x8*)(qp + 16 * s); }
    float mrun = a.in[22][head] * LOG2E, l = hi == 0 ? 1.f : 0.f;
    f32x16 o[4];
#pragma unroll
    for (int d = 0; d < 4; ++d)
#pragma unroll
        for (int r = 0; r < 16; ++r) o[d][r] = 0.f;
    int kstart = 0, nloc = 4;
    if (lat) { kstart = (qb - 1) * 128; if (kstart < 0) kstart = 0; int kend = (qb + 2) * 128; if (kend > 1024) kend = 1024; nloc = (kend - kstart) >> 6; }
    const int nt = lat ? nloc + 4 : 4;
    const int qpos = qloc + n;
    const int skey = tid >> 4, schk = tid & 15;
    u32x4 kreg[2], vreg[2];
#define ATT_SRC(t, off) do { if (!lat) off = (size_t)(rb + 64 * (t)) * 256 + kvh * 128; else if ((t) < nloc) off = (size_t)(rb + kstart + 64 * (t)) * 256 + kvh * 128; else off = (size_t)(lb * 256 + 64 * ((t) - nloc)) * 256 + kvh * 128; } while (0)
#define ATT_ISSUE(t) do { size_t off_; ATT_SRC(t, off_); const bool ctx_ = lat && (t) >= nloc; const bf16_t* ks_ = (ctx_ ? CK : Kb) + off_; const bf16_t* vs_ = (ctx_ ? CV : Vb) + off_; \
        _Pragma("unroll") for (int i_ = 0; i_ < 2; ++i_) { kreg[i_] = *(const u32x4*)(ks_ + (size_t)(skey + 32 * i_) * 256 + schk * 8); vreg[i_] = *(const u32x4*)(vs_ + (size_t)(skey + 32 * i_) * 256 + schk * 8); } } while (0)
    ATT_ISSUE(0);
    for (int t = 0; t < nt; ++t) {
        const bool lmask = lat && t < nloc; const int kpos0 = kstart + 64 * t;
        __syncthreads();
#pragma unroll
        for (int i = 0; i < 2; ++i) { const int key = skey + 32 * i;
            *(LAS u32x4*)(Ks + key * 272 + schk * 16) = kreg[i];
            const u32x4 vv = vreg[i];
            LAS unsigned short* vd = (LAS unsigned short*)(Vt + (schk * 8) * 144 + key * 2);
            vd[0 * 72] = (unsigned short)(vv.x & 0xffffu); vd[1 * 72] = (unsigned short)(vv.x >> 16); vd[2 * 72] = (unsigned short)(vv.y & 0xffffu); vd[3 * 72] = (unsigned short)(vv.y >> 16);
            vd[4 * 72] = (unsigned short)(vv.z & 0xffffu); vd[5 * 72] = (unsigned short)(vv.z >> 16); vd[6 * 72] = (unsigned short)(vv.w & 0xffffu); vd[7 * 72] = (unsigned short)(vv.w >> 16); }
        if (t + 1 < nt) ATT_ISSUE(t + 1);
        __syncthreads();
        f32x16 p0, p1;
#pragma unroll
        for (int r = 0; r < 16; ++r) { p0[r] = 0.f; p1[r] = 0.f; }
#pragma unroll
        for (int s = 0; s < 8; ++s) { const bf16x8 k0 = *(const LAS bf16x8*)(Ks + n * 272 + (16 * s + 8 * hi) * 2); const bf16x8 k1 = *(const LAS bf16x8*)(Ks + (32 + n) * 272 + (16 * s + 8 * hi) * 2);
            p0 = __builtin_amdgcn_mfma_f32_32x32x16_bf16(k0, qf[s], p0, 0, 0, 0); p1 = __builtin_amdgcn_mfma_f32_32x32x16_bf16(k1, qf[s], p1, 0, 0, 0); }
        if (lmask) {
#pragma unroll
            for (int r = 0; r < 16; ++r) { const int kp = kpos0 + crow(r, hi); int d0 = qpos - kp; d0 = d0 < 0 ? -d0 : d0; int d1 = qpos - kp - 32; d1 = d1 < 0 ? -d1 : d1;
                if (d0 > 128) p0[r] = -1e30f; if (d1 > 128) p1[r] = -1e30f; } }
        float rm = fmaxf(p0[0], p1[0]);
#pragma unroll
        for (int r = 1; r < 16; ++r) rm = fmaxf(rm, fmaxf(p0[r], p1[r]));
        rm = fmaxf(rm, __shfl_xor(rm, 32));
        const float mn = fmaxf(mrun, rm); const float f = __builtin_amdgcn_exp2f(mrun - mn); mrun = mn;
        float ls = 0.f;
#pragma unroll
        for (int r = 0; r < 16; ++r) { p0[r] = __builtin_amdgcn_exp2f(p0[r] - mn); p1[r] = __builtin_amdgcn_exp2f(p1[r] - mn); ls += p0[r] + p1[r]; }
        l = l * f + ls;
        if (__any(f != 1.f)) {
            if (hi == 0) wsf[n] = f;
            asm volatile("s_waitcnt lgkmcnt(0)" ::: "memory");
#pragma unroll
            for (int r = 0; r < 16; ++r) { const float fr_ = wsf[crow(r, hi)];
#pragma unroll
                for (int d = 0; d < 4; ++d) o[d][r] *= fr_; }
        }
        bf16x8 pa[4];
        { u32x4 t0, t1, t2, t3;
          t0.x = cvt_pk_bf16(p0[0], p0[1]); t0.y = cvt_pk_bf16(p0[2], p0[3]); t0.z = cvt_pk_bf16(p0[4], p0[5]); t0.w = cvt_pk_bf16(p0[6], p0[7]);
          t1.x = cvt_pk_bf16(p0[8], p0[9]); t1.y = cvt_pk_bf16(p0[10], p0[11]); t1.z = cvt_pk_bf16(p0[12], p0[13]); t1.w = cvt_pk_bf16(p0[14], p0[15]);
          t2.x = cvt_pk_bf16(p1[0], p1[1]); t2.y = cvt_pk_bf16(p1[2], p1[3]); t2.z = cvt_pk_bf16(p1[4], p1[5]); t2.w = cvt_pk_bf16(p1[6], p1[7]);
          t3.x = cvt_pk_bf16(p1[8], p1[9]); t3.y = cvt_pk_bf16(p1[10], p1[11]); t3.z = cvt_pk_bf16(p1[12], p1[13]); t3.w = cvt_pk_bf16(p1[14], p1[15]);
          pa[0] = __builtin_bit_cast(bf16x8, t0); pa[1] = __builtin_bit_cast(bf16x8, t1); pa[2] = __builtin_bit_cast(bf16x8, t2); pa[3] = __builtin_bit_cast(bf16x8, t3); }
#pragma unroll
        for (int d = 0; d < 4; ++d)
#pragma unroll
            for (int s = 0; s < 4; ++s) { const LAS unsigned char* vp = Vt + (32 * d + n) * 144 + (16 * s + 4 * hi) * 2;
                const u32x2 lo = *(const LAS u32x2*)vp, hi2 = *(const LAS u32x2*)(vp + 16);
                const u32x4 bw = (u32x4){lo.x, lo.y, hi2.x, hi2.y};
                o[d] = __builtin_amdgcn_mfma_f32_32x32x16_bf16(pa[s], __builtin_bit_cast(bf16x8, bw), o[d], 0, 0, 0); }
    }
#undef ATT_SRC
#undef ATT_ISSUE
    l += __shfl_xor(l, 32);
    if (hi == 0) wsf[32 + n] = 1.f / l;
    asm volatile("s_waitcnt lgkmcnt(0)" ::: "memory");
#pragma unroll
    for (int r = 0; r < 16; ++r) { const float iv = wsf[32 + crow(r, hi)]; bf16_t* op = ZO + (size_t)(rb + qloc + crow(r, hi)) * 2048 + 1024 + head * 128 + n;
#pragma unroll
        for (int d = 0; d < 4; ++d) op[32 * d] = (bf16_t)(cvt_pk_bf16(o[d][r] * iv, 0.f) & 0xffffu); }
}

__device__ __forceinline__ float gelu_tanh(float y) { const float t = 1.5957691216057308f * (y + 0.044715f * y * y * y); return y * __builtin_amdgcn_rcpf(1.f + __expf(-t)); }
__device__ __forceinline__ f32x4 gelu4(f32x4 v) { return (f32x4){gelu_tanh(v[0]), gelu_tanh(v[1]), gelu_tanh(v[2]), gelu_tanh(v[3])}; }
__device__ __forceinline__ void ssm_consts(const Args& a, int gi, int n, int hi, float (&lr)[2], float (&li)[2], bf16x8 (&Bf)[4], bf16x8 (&Cf)[8]) {
    const float dt = __expf(a.in[15][gi]);
    float kr[2], ki[2];
#pragma unroll
    for (int st = 0; st < 2; ++st) { const int p = n + 32 * st; const float lre = a.in[13][gi * 64 + p], lim = a.in[14][gi * 64 + p];
        const float mag = __expf(lre * dt); float s, c; sincos_rr(lim * dt, s, c); lr[st] = mag * c; li[st] = mag * s;
        const float den = 1.f / (lre * lre + lim * lim), nr = lr[st] - 1.f; kr[st] = (nr * lre + li[st] * lim) * den; ki[st] = (li[st] * lre - nr * lim) * den; }
#pragma unroll
    for (int nb = 0; nb < 4; ++nb) { const int st = nb & 1, part = nb >> 1, p = n + 32 * st; const float* br = a.in[16] + (size_t)(gi * 64 + p) * 16 + 8 * hi; const float* bi = a.in[17] + (size_t)(gi * 64 + p) * 16 + 8 * hi;
        float v[8];
#pragma unroll
        for (int j = 0; j < 8; ++j) v[j] = part == 0 ? kr[st] * br[j] - ki[st] * bi[j] : kr[st] * bi[j] + ki[st] * br[j];
        u32x4 t; t.x = cvt_pk_bf16(v[0], v[1]); t.y = cvt_pk_bf16(v[2], v[3]); t.z = cvt_pk_bf16(v[4], v[5]); t.w = cvt_pk_bf16(v[6], v[7]); Bf[nb] = __builtin_bit_cast(bf16x8, t); }
#pragma unroll
    for (int s = 0; s < 8; ++s) { float v[8];
#pragma unroll
        for (int j = 0; j < 8; ++j) { const int np = 4 * s + 2 * hi + (j >> 2), q = j & 3, p = np + 32 * (q & 1); const int cc = n & 15;
            const float x = q < 2 ? a.in[18][(size_t)(gi * 16 + cc) * 64 + p] : -a.in[19][(size_t)(gi * 16 + cc) * 64 + p]; v[j] = n < 16 ? x : 0.f; }
        u32x4 t; t.x = cvt_pk_bf16(v[0], v[1]); t.y = cvt_pk_bf16(v[2], v[3]); t.z = cvt_pk_bf16(v[4], v[5]); t.w = cvt_pk_bf16(v[6], v[7]); Cf[s] = __builtin_bit_cast(bf16x8, t); }
}
template <bool FULL> __device__ __forceinline__ void ssm_chunk(const bf16x8 Af, const bf16x8 (&Bf)[4], const bf16x8 (&Cf)[8], const float (&lr)[2], const float (&li)[2], float (&hr)[2], float (&hm)[2], LAS unsigned char* hl, int n, int hi, f32x16& Y) {
    f32x16 D[4];
#pragma unroll
    for (int nb = 0; nb < 4; ++nb) {
#pragma unroll
        for (int r = 0; r < 16; ++r) D[nb][r] = 0.f;
        D[nb] = __builtin_amdgcn_mfma_f32_32x32x16_bf16(Af, Bf[nb], D[nb], 0, 0, 0); }
    typedef float f32x2 __attribute__((ext_vector_type(2)));
    const f32x2 lr2 = (f32x2){lr[0], lr[1]}, li2 = (f32x2){li[0], li[1]}; f32x2 hr2 = (f32x2){hr[0], hr[1]}, hm2 = (f32x2){hm[0], hm[1]};
#pragma unroll
    for (int r = 0; r < 16; ++r) {
        const f32x2 dre = (f32x2){D[0][r], D[1][r]}, dim = (f32x2){D[2][r], D[3][r]};
        const f32x2 nr = __builtin_elementwise_fma(lr2, hr2, __builtin_elementwise_fma(-li2, hm2, dre));
        const f32x2 ni = __builtin_elementwise_fma(lr2, hm2, __builtin_elementwise_fma(li2, hr2, dim));
        hr2 = nr; hm2 = ni;
        if (FULL) { u32x2 pk; pk.x = cvt_pk_bf16(hr2[0], hr2[1]); pk.y = cvt_pk_bf16(hm2[0], hm2[1]); *(LAS u32x2*)(hl + crow(r, hi) * 272 + n * 8) = pk; } }
    hr[0] = hr2[0]; hr[1] = hr2[1]; hm[0] = hm2[0]; hm[1] = hm2[1];
    if (FULL) {
#pragma unroll
        for (int r = 0; r < 16; ++r) Y[r] = 0.f;
#pragma unroll
        for (int s = 0; s < 8; ++s) { const bf16x8 af = *(const LAS bf16x8*)(hl + n * 272 + (16 * s + 8 * hi) * 2); Y = __builtin_amdgcn_mfma_f32_32x32x16_bf16(af, Cf[s], Y, 0, 0, 0); }
    }
}
__device__ __forceinline__ void ssm_prompt_block(const Args& a, LAS unsigned char* lds, int task) {
    const int tid = threadIdx.x, lane = tid & 63, w = __builtin_amdgcn_readfirstlane(tid >> 6);
    LAS unsigned char* hl = lds + 40960 + w * 8704;
    const int d = w & 1, t2 = task * 4 + (w >> 1), g = t2 & 63, pair = t2 >> 6;
    const int n = lane & 31, hi = lane >> 5;
    const int ahalf = (n >> 2) & 1, atau = (n & 3) + 4 * (n >> 3);
    const int rbA = (2 * pair + ahalf) * 256, rbO = (2 * pair + hi) * 256, bO = 2 * pair + hi;
    const bf16_t* U = (const bf16_t*)(a.ws + WS_U); float* YF = (float*)(a.ws + WS_YF); bf16_t* Z = (bf16_t*)(a.ws + WS_Z);
    float* YBh = (float*)(a.ws + (pair < 8 ? WS_YBP0 : WS_YBP1)); const int hoff = pair < 8 ? 0 : 4096;
    float* out_re = a.out + 25165824; float* out_im = out_re + 262144;
    const int col = g * 16 + (n & 15);
    {
        const int gi = d * 64 + g;
        float lr[2], li[2]; bf16x8 Bf[4], Cf[8];
        ssm_consts(a, gi, n, hi, lr, li, Bf, Cf);
        float hr[2] = {0.f, 0.f}, hm[2] = {0.f, 0.f};
        const bf16_t* ua = U + (size_t)rbA * 1024 + g * 16 + 8 * hi;
        float* yo = (d == 0 ? YF + ((size_t)g * 10240 + rbO) * 16 : YBh + ((size_t)g * 4096 + rbO - hoff) * 16) + (n & 15);
        for (int grp = 0; grp < 2; ++grp) {
            bf16x8 A8[8];
#pragma unroll
            for (int c = 0; c < 8; ++c) { const int tk = 16 * (8 * grp + c) + atau; A8[c] = *(const bf16x8*)(ua + (size_t)(d == 0 ? tk : 255 - tk) * 1024); }
#pragma unroll
            for (int c = 0; c < 8; ++c) { const int ch = 8 * grp + c;
                f32x16 Y;
                ssm_chunk<true>(A8[c], Bf, Cf, lr, li, hr, hm, hl, n, hi, Y);
                if (n < 16) {
#pragma unroll
                    for (int r = 0; r < 16; ++r) { const int tok = d == 0 ? 16 * ch + r : 255 - (16 * ch + r); yo[tok * 16] = Y[r]; } } }
        }
#pragma unroll
        for (int st = 0; st < 2; ++st) { const size_t si = ((size_t)(bO * 2 + d) * 64 + g) * 64 + n + 32 * st; out_re[si] = hr[st]; out_im[si] = hm[st]; }
    }
    asm volatile("s_waitcnt vmcnt(0)" ::: "memory");
    __syncthreads();
    { const int c4 = (lane & 3) * 4; const f32x4 dc = *(const f32x4*)(a.in[20] + g * 16 + c4); const int row0 = (2 * pair + (w & 1)) * 256 + (lane >> 2);
      for (int b2 = 0; b2 < 2; ++b2) { f32x4 yf[8], yb[8]; u32x2 uu[8];
#pragma unroll
          for (int i = 0; i < 8; ++i) { const int row = row0 + (b2 * 8 + i) * 16; yf[i] = *(const f32x4*)(YF + ((size_t)g * 10240 + row) * 16 + c4); yb[i] = *(const f32x4*)(YBh + ((size_t)g * 4096 + row - hoff) * 16 + c4);
              uu[i] = *(const u32x2*)(U + (size_t)row * 1024 + g * 16 + c4); }
#pragma unroll
          for (int i = 0; i < 8; ++i) { const int row = row0 + (b2 * 8 + i) * 16; *(u32x2*)(Z + (size_t)row * 1024 + g * 16 + c4) = pack4(gelu4(unpack4(uu[i]) * dc + yf[i] + yb[i])); } } }
}
__device__ __forceinline__ void ssm_latent_block(const Args& a, LAS unsigned char* lds, int g) {
    const int tid = threadIdx.x, lane = tid & 63, w = __builtin_amdgcn_readfirstlane(tid >> 6), n = lane & 31, hi = lane >> 5;
    const int seg = w & 3, d = w >> 2, gi = d * 64 + g;
    LAS unsigned char* hl = lds + 40960 + w * 8704; LAS float* Ex = (LAS float*)(lds + 40960 + 8 * 8704);
    const int ahalf = (n >> 2) & 1, atau = (n & 3) + 4 * (n >> 3);
    const bf16_t* U = (const bf16_t*)(a.ws + WS_U); float* YF = (float*)(a.ws + WS_YF); float* YB = (float*)(a.ws + WS_YBL); bf16_t* Z = (bf16_t*)(a.ws + WS_Z);
    float lr[2], li[2]; bf16x8 Bf[4], Cf[8];
    ssm_consts(a, gi, n, hi, lr, li, Bf, Cf);
    float pr[2], pi[2];
#pragma unroll
    for (int st = 0; st < 2; ++st) { float x = lr[st], y = li[st];
#pragma unroll
        for (int k = 0; k < 8; ++k) { const float nx = x * x - y * y, ny = 2.f * x * y; x = nx; y = ny; }
        pr[st] = x; pi[st] = y; }
    const bf16_t* ua = U + (size_t)(NPROMPT + ahalf * 1024 + seg * 256) * 1024 + g * 16 + 8 * hi;
    f32x16 Y;
    float hr[2] = {0.f, 0.f}, hm[2] = {0.f, 0.f};
    for (int grp = 0; grp < 2; ++grp) { bf16x8 A8[8];
#pragma unroll
        for (int c = 0; c < 8; ++c) { const int tk = 16 * (8 * grp + c) + atau; A8[c] = *(const bf16x8*)(ua + (size_t)(d == 0 ? tk : 255 - tk) * 1024); }
#pragma unroll
        for (int c = 0; c < 8; ++c) ssm_chunk<false>(A8[c], Bf, Cf, lr, li, hr, hm, hl, n, hi, Y); }
#pragma unroll
    for (int st = 0; st < 2; ++st) { LAS float* e = Ex + ((((d * 4 + seg) * 2 + hi) * 64) + n + 32 * st) * 2; e[0] = hr[st]; e[1] = hm[st]; }
    __syncthreads();
#pragma unroll
    for (int st = 0; st < 2; ++st) { const size_t si = ((size_t)(hi * 2 + d) * 64 + g) * 64 + n + 32 * st; float x = a.in[4][si], y = a.in[5][si];
        for (int k = 0; k < 3; ++k) { const int s = d == 0 ? k : 3 - k; const bool go = d == 0 ? (s < seg) : (s > seg);
            if (go) { const LAS float* e = Ex + ((((d * 4 + s) * 2 + hi) * 64) + n + 32 * st) * 2; const float nx = pr[st] * x - pi[st] * y + e[0], ny = pr[st] * y + pi[st] * x + e[1]; x = nx; y = ny; } }
        hr[st] = x; hm[st] = y; }
    { float* yo = (d == 0 ? YF + ((size_t)g * 10240 + NPROMPT + hi * 1024 + seg * 256) * 16 : YB + ((size_t)g * 2048 + hi * 1024 + seg * 256) * 16) + (n & 15);
      for (int grp = 0; grp < 2; ++grp) { bf16x8 A8[8];
#pragma unroll
          for (int c = 0; c < 8; ++c) { const int tk = 16 * (8 * grp + c) + atau; A8[c] = *(const bf16x8*)(ua + (size_t)(d == 0 ? tk : 255 - tk) * 1024); }
#pragma unroll
          for (int c = 0; c < 8; ++c) { const int ch = 8 * grp + c;
              ssm_chunk<true>(A8[c], Bf, Cf, lr, li, hr, hm, hl, n, hi, Y);
              if (n < 16) {
#pragma unroll
                  for (int r = 0; r < 16; ++r) { const int tok = d == 0 ? 16 * ch + r : 255 - (16 * ch + r); yo[tok * 16] = Y[r]; } } } } }
    __threadfence(); __syncthreads();
    { const int c4 = (tid & 3) * 4; const f32x4 dc = *(const f32x4*)(a.in[20] + g * 16 + c4);
      for (int b2 = 0; b2 < 2; ++b2) { f32x4 yf[8], yb[8]; u32x2 uu[8];
#pragma unroll
          for (int i = 0; i < 8; ++i) { const int rl = (tid >> 2) + (b2 * 8 + i) * 128; yf[i] = *(const f32x4*)(YF + ((size_t)g * 10240 + NPROMPT + rl) * 16 + c4); yb[i] = *(const f32x4*)(YB + ((size_t)g * 2048 + rl) * 16 + c4);
              uu[i] = *(const u32x2*)(U + (size_t)(NPROMPT + rl) * 1024 + g * 16 + c4); }
#pragma unroll
          for (int i = 0; i < 8; ++i) { const int rl = (tid >> 2) + (b2 * 8 + i) * 128; *(u32x2*)(Z + (size_t)(NPROMPT + rl) * 1024 + g * 16 + c4) = pack4(gelu4(unpack4(uu[i]) * dc + yf[i] + yb[i])); } } }
    __syncthreads();
}

#define XB_TMO      128
#define XB_XCNT(j)  (256  + 64 * (j))
#define XB_XSUB(j)  (1280 + 64 * (j))
#define XB_XGEN(j)  (2304 + 64 * (j))
#define XB_TOP      3328
#define XB_TOPGEN   3392
#define XCD_BAR_WORDS 3456
#define XB_SPIN_CAP (1u << 22)
__device__ __forceinline__ unsigned xb_ld(unsigned* p)              { return __hip_atomic_load(p, __ATOMIC_RELAXED, __HIP_MEMORY_SCOPE_AGENT); }
__device__ __forceinline__ unsigned xb_add(unsigned* p, unsigned v) { return __hip_atomic_fetch_add(p, v, __ATOMIC_RELAXED, __HIP_MEMORY_SCOPE_AGENT); }
__device__ __forceinline__ unsigned xb_xcc_id() { return (unsigned)__builtin_amdgcn_s_getreg((3 << 11) | 20) & 0xFu; }
#define XB_SPIN(cond, bar) do { unsigned _sp = 0; while (cond) { __builtin_amdgcn_s_sleep(1); \
    if ((++_sp & 255u) == 0u) { if (xb_ld(&(bar)[XB_TMO])) break; if (_sp > XB_SPIN_CAP) { atomicAdd(&(bar)[XB_TMO], 1u); break; } } } } while (0)
struct XcdBarrier { unsigned* bar; unsigned x; volatile LAS unsigned* st; };
__device__ __forceinline__ XcdBarrier xcd_barrier_post(unsigned* bar, volatile LAS unsigned* st) {
    XcdBarrier b; b.bar = bar; b.x = xb_xcc_id(); b.st = st;
    if (threadIdx.x == 0) (void)xb_add(&bar[XB_XCNT(b.x)], 1u);
    return b;
}
__device__ __forceinline__ void xcd_barrier_complete(unsigned* bar, unsigned x, unsigned& nloc, unsigned& nx) {
    const unsigned G = gridDim.x * gridDim.y * gridDim.z;
    unsigned sum, cnt, mine, sp = 0u;
    for (;;) {
        sum = 0u; cnt = 0u; mine = 0u;
#pragma unroll
        for (unsigned j = 0; j < 16; ++j) { const unsigned c = xb_ld(&bar[XB_XCNT(j)]); sum += c; cnt += (c > 0u) ? 1u : 0u; mine = (j == x) ? c : mine; }
        if (sum == G) break;
        __builtin_amdgcn_s_sleep(1);
        if ((++sp & 255u) == 0u) { if (xb_ld(&bar[XB_TMO])) break; if (sp > XB_SPIN_CAP) { atomicAdd(&bar[XB_TMO], 1u); break; } }
    }
    nloc = mine > 0u ? mine : 1u; nx = cnt > 0u ? cnt : 1u;
}
__device__ __forceinline__ void xcd_barrier(const XcdBarrier& b) {
    asm volatile("s_waitcnt vmcnt(0)" ::: "memory");
    __syncthreads();
    if (threadIdx.x == 0) {
        unsigned* bar = b.bar;
        __builtin_amdgcn_s_waitcnt(0);
        unsigned nloc = b.st[0], nx = b.st[1];
        if (nloc == 0u) { xcd_barrier_complete(bar, b.x, nloc, nx); b.st[0] = nloc; b.st[1] = nx; }
        const unsigned old = xb_add(&bar[XB_XSUB(b.x)], 1u);
        const unsigned gen = old / nloc;
        if (old + 1u == (gen + 1u) * nloc) {
            __builtin_amdgcn_fence(__ATOMIC_RELEASE, "agent");
            asm volatile("s_waitcnt vmcnt(0)" ::: "memory");
            const unsigned og = xb_add(&bar[XB_TOP], 1u);
            const unsigned tg = og / nx;
            if (og + 1u == (tg + 1u) * nx) xb_add(&bar[XB_TOPGEN], 1u);
            else XB_SPIN(xb_ld(&bar[XB_TOPGEN]) == tg, bar);
            __builtin_amdgcn_fence(__ATOMIC_ACQUIRE, "agent");
            xb_add(&bar[XB_XGEN(b.x)], 1u);
            asm volatile("s_waitcnt vmcnt(0)" ::: "memory");
        } else {
            XB_SPIN(xb_ld(&bar[XB_XGEN(b.x)]) == gen, bar);
            __builtin_amdgcn_fence(__ATOMIC_ACQUIRE, "agent");
            asm volatile("s_waitcnt vmcnt(0)" ::: "memory");
        }
    }
    __syncthreads();
}

__global__ void __launch_bounds__(512, 2) mk_fwd(Args a) {
    extern __shared__ __attribute__((aligned(16))) unsigned char lds_raw[];
    LAS unsigned char* lds = (LAS unsigned char*)lds_raw;
    cg::grid_group grid = cg::this_grid();
    const int lo = a.ph_lo, hi = a.ph_hi;
    const int tid = threadIdx.x, lane = tid & 63, wave = __builtin_amdgcn_readfirstlane(tid >> 6);
    const int G = gridDim.x;
#define IN(k) (lo <= (k) && (k) < hi)
#define SEAM(k) do { if (IN(k) && IN((k) + 1)) { xcd_barrier(xbar); } } while (0)
    unsigned char* ws = a.ws;
    float* mod = (float*)(ws + WS_MOD);
    if (lo > 1000) grid.sync();
    volatile LAS unsigned* xst = (volatile LAS unsigned*)(lds + LDS_EX + 16384);
    if (tid < 2) xst[tid] = 0u;
    __syncthreads();
    XcdBarrier xbar; xbar.bar = (unsigned*)(ws + WS_BAR); xbar.x = 0; xbar.st = xst;
    if (hi - lo > 1) xbar = xcd_barrier_post((unsigned*)(ws + WS_BAR), xst);

    if (IN(0)) { phase0(a, lds); } SEAM(0);
    if (IN(1)) { for (int rep_ = 0; rep_ < P1_REP; ++rep_) { if (rep_) __syncthreads(); phase1(a, lds); } } SEAM(1);
    if (IN(2)) {
        pg8::Gemm g{(const bf16_t*)(ws + WS_XM), (const bf16_t*)(ws + WS_WIN), 2048, 2048, nullptr, nullptr};
        EpiWin E{(bf16_t*)(ws + WS_U), (bf16_t*)(ws + WS_Q), (bf16_t*)(ws + WS_K), (bf16_t*)(ws + WS_V), (bf16_t*)(ws + WS_GS), (bf16_t*)(ws + WS_GA),
                 a.out + 20971520, a.out + 20971520 + 2097152, (const float*)(ws + WS_ROPEC), (const float*)(ws + WS_ROPES)};
        if (G == 256) { WinOrder S{G, (int)blockIdx.x}; pg8::gemm_phase(lds, g, S, E); }
        else { pg8::StaticOrder S; S.init(40, 26, G, (int)blockIdx.x, 32, 1); pg8::gemm_phase(lds, g, S, E); }
    } SEAM(2);
    if (IN(3)) {
        volatile LAS unsigned* qs = (volatile LAS unsigned*)(lds + LDS_EX + 16384 + 16);
        unsigned* qctr = (unsigned*)(ws + WS_QCTR);
        const int n_g = (G == 256) ? 16 : 0; const int e0 = n_g, e1 = e0 + 64, e2 = e1 + 256, e3 = e2 + 64, e4 = e3 + 256;
        int t = (int)blockIdx.x;
#define QNEXT() do { __syncthreads(); if (tid == 0) qs[0] = (unsigned)G + atomicAdd(qctr, 1u); __syncthreads(); t = (int)qs[0]; } while (0)
        if (G == 256) {
            pg8::Gemm g{(const bf16_t*)(ws + WS_XM), (const bf16_t*)(ws + WS_WIN), 2048, 2048, nullptr, nullptr};
            EpiWin E{(bf16_t*)(ws + WS_U), (bf16_t*)(ws + WS_Q), (bf16_t*)(ws + WS_K), (bf16_t*)(ws + WS_V), (bf16_t*)(ws + WS_GS), (bf16_t*)(ws + WS_GA),
                     a.out + 20971520, a.out + 20971520 + 2097152, (const float*)(ws + WS_ROPEC), (const float*)(ws + WS_ROPES)};
            while (t < e0) { win_unit(lds, g, E, t); QNEXT(); }
        }
        while (t < e1) { ssm_latent_block(a, lds, t - e0); QNEXT(); }
        while (t < e2) { ssm_prompt_block(a, lds, t - e1); QNEXT(); }
        while (t < e3) { attn_unit(a, lds, t - e2); QNEXT(); }
        while (t < e4) { attn_unit(a, lds, 64 + (t - e3)); QNEXT(); }
        while (t < e4 + 144) { __syncthreads(); for (int k = 0; k < 4; ++k) small_weight_item(a, (LAS float*)(lds + wave * 8704), ((t - e4) * 4 + k) * 8 + wave, lane); QNEXT(); }
#undef QNEXT
        shv2_rows(a);
    } SEAM(3);
    if (IN(4)) {
        pg8::Gemm g{(const bf16_t*)(ws + WS_Z), (const bf16_t*)(ws + WS_WGLU), 1024, 1024, nullptr, nullptr}; pg8::StaticOrder S; S.init(40, 4, G, (int)blockIdx.x, 16, 1);
        EpiGlu E{(const bf16_t*)(ws + WS_Z), (bf16_t*)(ws + WS_ZO)};
        pg8::gemm_phase(lds, g, S, E);
        { Unit u0; const int nbusy = S.nwg < G ? S.nwg : G;
          const bool idle = !S.next(0, u0); const int nidle = G - nbusy;
          if (nidle > 0 ? idle : true) { const int wid0 = nidle > 0 ? ((int)blockIdx.x - nbusy) * 8 + wave : (int)blockIdx.x * 8 + wave, nw = (nidle > 0 ? nidle : G) * 8;
              __syncthreads();
              for (int it = wid0; it < 88 * 64; it += nw) transpose_item<0>(a.in[29], 2048, (bf16_t*)(ws + WS_WDN), DFF, 0, (LAS float*)(lds + wave * 8704), it, lane, nullptr, nullptr); } }
    } SEAM(4);
    if (IN(5)) {
        pg8::Gemm g{(const bf16_t*)(ws + WS_ZO), (const bf16_t*)(ws + WS_WM), 2048, 2048, (float*)(ws + 128 * MiB), (unsigned*)(ws + WS_SPCNT) + 256}; PairOrder S; S.S.init(40, 8, G, (int)blockIdx.x, 32, 1); S.S.qm = true;
        EpiMerged E{(const bf16_t*)(ws + WS_GS), (const bf16_t*)(ws + WS_GA), (bf16_t*)(ws + WS_MERGED)};
        pg8::gemm_phase(lds, g, S, E);
    } SEAM(5);
    if (IN(6)) {
        pg8::Gemm g{(const bf16_t*)(ws + WS_MERGED), (const bf16_t*)(ws + WS_WOUT), 2048, 2048, (float*)(ws + 160 * MiB), (unsigned*)(ws + WS_SPCNT) + 512}; pg8::StaticOrder S; S.init(40, 8, G, (int)blockIdx.x, 32, 1); S.qm = true;
        EpiRes<true> E{a.in[0], a.in[1], nullptr, true, a.out, mod, 2 * 2048, (const float*)(ws + WS_G2), (bf16_t*)(ws + WS_XM), (float*)(ws + WS_RS1), nullptr};
        pg8::gemm_phase(lds, g, S, E);
    } SEAM(6);
    if (IN(7)) {
        pg8::Gemm g{(const bf16_t*)(ws + WS_XM), (const bf16_t*)(ws + WS_WUP), 2048, LDWUP, (float*)(ws + 288 * MiB), (unsigned*)(ws + WS_SPCNT) + 768}; pg8::StaticOrder S; S.init(40, 44, G, (int)blockIdx.x, 32, 1);
        EpiUp E{(const float*)(ws + WS_RS1), (const float*)(ws + WS_SHV2), a.in[27], a.in[28], (bf16_t*)(ws + WS_ACT), (float*)(ws + WS_HBP), (float*)(ws + WS_HBH)};
        pg8::gemm_phase(lds, g, S, E);
    } SEAM(7);
    if (IN(8)) {
        {
          const float* hbp = (const float*)(ws + WS_HBP); const float* hbh = (const float*)(ws + WS_HBH); const float* cw = a.in[27]; bf16_t* ACT = (bf16_t*)(ws + WS_ACT);
          const bool own = (G == 256); const int c_ = (int)blockIdx.x; const int t_own = (c_ >> 2) & 7, q_lo = (c_ & 3) * 1408;
          const int n_it = own ? 2 * 1408 : 16 * DFF;
          for (int idx = own ? tid : blockIdx.x * 512 + tid; idx < n_it; idx += own ? 512 : G * 512) {
              int tw, q; if (own) { const int which_ = idx / 1408; tw = t_own * 2 + which_; q = q_lo + (idx - which_ * 1408); } else { tw = idx / DFF; q = idx - tw * DFF; }
              const int t = tw >> 1, which = tw & 1, j = t & 3;
              if ((which == 0 && j == 0) || (which == 1 && j == 3)) continue;
              const int nbr = which == 0 ? (t - 1) * 2 + 1 : (t + 1) * 2; const float* wt = cw + (which == 0 ? 0 : 2 * NUP);
              const float av = hbp[(size_t)tw * NUP + q] + wt[q] * hbh[(size_t)nbr * NUP + q];
              const float bv = hbp[(size_t)tw * NUP + DFF + q] + wt[DFF + q] * hbh[(size_t)nbr * NUP + DFF + q];
              ACT[(size_t)(NPROMPT + t * 256 + (which ? 255 : 0)) * DFF + q] = (bf16_t)(cvt_pk_bf16(av * sigmoidf(av) * bv, 0.f) & 0xffffu); }
          asm volatile("s_waitcnt vmcnt(0)" ::: "memory");
          if (own) __syncthreads(); else if (hi - lo > 1) xcd_barrier(xbar); }
        pg8::Gemm g{(const bf16_t*)(ws + WS_ACT), (const bf16_t*)(ws + WS_WDN), DFF, DFF, nullptr, nullptr}; DownOrder S; S.S.init(40, 8, G, (int)blockIdx.x, 88, 1); S.split = (G == 256);
        EpiDown E{a.out, mod, (float*)(ws + WS_RS2), (float*)(ws + WS_PART8), a.in[30], (float*)(ws + WS_XCH), (unsigned*)(ws + WS_PCNT), G == 256};
        pg8::gemm_phase(lds, g, S, E);
    } SEAM(8);
    if (IN(9)) {
        const int gw = blockIdx.x * 8 + wave, NGW = G * 8; const float* rs2 = (const float*)(ws + WS_RS2); const float* fg = a.in[30]; const bool split = (G == 256);
        for (int m = (split ? NPROMPT : 0) + gw; m < MT; m += NGW) { float* yr = a.out + (size_t)m * DM;
            f32x4 v[8];
#pragma unroll
            for (int j = 0; j < 8; ++j) v[j] = *(const f32x4*)(yr + 4 * lane + 256 * j);
            float rstd;
            if (split && m >= NPROMPT) { const float* pp = (const float*)(ws + WS_PART8) + (size_t)(m - NPROMPT) * 2048 + 4 * lane; float ss = 0.f;
#pragma unroll
                for (int j = 0; j < 8; ++j) { v[j] += (*(const f32x4*)(pp + 256 * j) + *(const f32x4*)(pp + 2048 * 2048 + 256 * j)) + (*(const f32x4*)(pp + 2 * 2048 * 2048 + 256 * j) + *(const f32x4*)(pp + 3 * 2048 * 2048 + 256 * j));
                    ss += (v[j][0] * v[j][0] + v[j][1] * v[j][1]) + (v[j][2] * v[j][2] + v[j][3] * v[j][3]); }
                rstd = rsqrtf(wave_sum(ss) * (1.f / DM) + EPS); }
            else rstd = rsqrtf(rs2[m] * (1.f / DM) + EPS);
#pragma unroll
            for (int j = 0; j < 8; ++j) { const int col = 4 * lane + 256 * j; *(f32x4*)(yr + col) = v[j] * rstd * *(const f32x4*)(fg + col); } }
    }
#undef IN
#undef SEAM
}

extern "C" void kernel_launch(void* const* d_in, const int* in_sizes, int n_in, void* d_out, int out_size, void* d_ws, size_t ws_size, hipStream_t stream) {
    static int grid = 0;
    if (grid == 0) {
        if (n_in != 31 || out_size != 25690112 || ws_size < WS_END) { fprintf(stderr, "kernel_launch: unexpected shapes: n_in %d out %d ws %zu (need %zu)\n", n_in, out_size, ws_size, (size_t)WS_END); grid = -1; return; }
        int dev = 0, cus = 0, per_cu = 0;
        hipGetDevice(&dev); hipDeviceGetAttribute(&cus, hipDeviceAttributeMultiprocessorCount, dev);
        hipFuncSetAttribute((const void*)mk_fwd, hipFuncAttributeMaxDynamicSharedMemorySize, LDS_BYTES);
        hipOccupancyMaxActiveBlocksPerMultiprocessor(&per_cu, (const void*)mk_fwd, 512, LDS_BYTES);
        if (per_cu < 1) { fprintf(stderr, "kernel_launch: occupancy query reports %d blocks per CU\n", per_cu); (void)hipGetLastError(); grid = -1; return; }
        grid = cus * per_cu;
    }
    if (grid < 0) return;
    hipMemsetAsync(d_ws, 0, ZERO_BYTES, stream);
    Args a{};
    for (int i = 0; i < 31; ++i) a.in[i] = (const float*)d_in[i];
    a.out = (float*)d_out; a.ws = (unsigned char*)d_ws;
#if MK_ONE_LAUNCH
    a.ph_lo = 0; a.ph_hi = NPH;
    { void* args[] = {&a}; hipError_t e = hipLaunchCooperativeKernel((const void*)mk_fwd, dim3(grid), dim3(512), args, LDS_BYTES, stream);
      if (e != hipSuccess) fprintf(stderr, "cooperative launch failed: %s (grid %d)\n", hipGetErrorString(e), grid); }
#else
    for (int p = 0; p < NPH; ++p) { a.ph_lo = p; a.ph_hi = p + 1; void* args[] = {&a};
        hipError_t e = hipLaunchCooperativeKernel((const void*)mk_fwd, dim3(grid), dim3(512), args, LDS_BYTES, stream);
        if (e != hipSuccess) { fprintf(stderr, "cooperative launch %d failed: %s (grid %d)\n", p, hipGetErrorString(e), grid); break; } }
#endif
}
```

```cpp
#include <hip/hip_runtime.h>
#include <hip/hip_cooperative_groups.h>
#include <cstdio>
#include <cstdint>
namespace cg = cooperative_groups;

#ifndef P1_REP
#define P1_REP 1
#endif
#ifndef MK_ONE_LAUNCH
#define MK_ONE_LAUNCH 1
#endif

#define LAS __attribute__((address_space(3)))
typedef unsigned short bf16_t;
typedef short bf16x8 __attribute__((ext_vector_type(8)));
typedef float f32x4 __attribute__((ext_vector_type(4)));
typedef float f32x16 __attribute__((ext_vector_type(16)));
typedef unsigned u32x4 __attribute__((ext_vector_type(4)));
typedef unsigned u32x2 __attribute__((ext_vector_type(2)));

constexpr int DM = 2048, NPROMPT = 8192, MT = 10240, INC = 6656, DFF = 5632, NUP = 11264;
constexpr float EPS = 1e-6f;
constexpr float LOG2E = 1.4426950408889634f;
constexpr float QSCALE = 0.08838834764831845f * LOG2E;
constexpr int NPH = 10;
constexpr int LDWUP = 2112;

constexpr size_t MiB = 1u << 20;
constexpr size_t WS_MOD = 0;
constexpr size_t WS_SHV2 = 147456;
constexpr size_t WS_RS1 = 282624;
constexpr size_t WS_RS2 = 323584;
constexpr size_t WS_BAR = 393216;
constexpr size_t WS_SPCNT = 417792;
constexpr size_t WS_QCTR = 409600;
constexpr size_t WS_PCNT = 425984;
constexpr size_t ZERO_BYTES = 512 * 1024;
constexpr size_t WS_G2 = 1 * MiB;
constexpr size_t WS_ROPEC = WS_G2 + 24576;
constexpr size_t WS_ROPES = WS_ROPEC + 8192;
constexpr size_t WS_CK = WS_G2 + 65536;
constexpr size_t WS_CV = WS_CK + 262144;
constexpr size_t WS_WIN = 8 * MiB;
constexpr size_t WS_WGLU = 34 * MiB;
constexpr size_t WS_WM = 36 * MiB;
constexpr size_t WS_WOUT = 44 * MiB;
constexpr size_t WS_WUP = 52 * MiB;
constexpr size_t WS_WDN = 368 * MiB;
constexpr size_t WS_XM = 118 * MiB;
constexpr size_t WS_Z = 118 * MiB;
constexpr size_t WS_U = 158 * MiB;
constexpr size_t WS_Q = 178 * MiB;
constexpr size_t WS_K = 198 * MiB;
constexpr size_t WS_V = 203 * MiB;
constexpr size_t WS_GS = 208 * MiB;
constexpr size_t WS_GA = 248 * MiB;
constexpr size_t WS_YF = 288 * MiB;
constexpr size_t WS_MERGED = 288 * MiB;
constexpr size_t WS_ZO = 328 * MiB;
constexpr size_t WS_ACT = 158 * MiB;
constexpr size_t WS_PART8 = 288 * MiB;
constexpr size_t WS_YBL = 368 * MiB;
constexpr size_t WS_HBP = 395 * MiB;
constexpr size_t WS_HBH = 396 * MiB;
constexpr size_t WS_YBP0 = 138 * MiB;
constexpr size_t WS_YBP1 = 378 * MiB;
constexpr size_t WS_XCH = 394 * MiB;
constexpr size_t WS_END = 397 * MiB;

constexpr int LDS_STAGE = 131072;
constexpr int LDS_EX = 131072;
constexpr int LDS_BYTES = 131072 + 16384 + 1024;

struct Args { const float* in[31]; float* out; unsigned char* ws; int ph_lo, ph_hi; };

typedef float f32x2_t __attribute__((ext_vector_type(2))); typedef __bf16 bf16x2_t __attribute__((ext_vector_type(2)));
__device__ __forceinline__ unsigned cvt_pk_bf16(float lo, float hi) { const f32x2_t v = {lo, hi}; const bf16x2_t b = __builtin_convertvector(v, bf16x2_t); return __builtin_bit_cast(unsigned, b); }
__device__ __forceinline__ float bf_lo(unsigned w) { return __uint_as_float(w << 16); }
__device__ __forceinline__ float bf_hi(unsigned w) { return __uint_as_float(w & 0xffff0000u); }
__device__ __forceinline__ f32x4 unpack4(u32x2 w) { return (f32x4){bf_lo(w.x), bf_hi(w.x), bf_lo(w.y), bf_hi(w.y)}; }
__device__ __forceinline__ u32x2 pack4(f32x4 v) { u32x2 w; w.x = cvt_pk_bf16(v[0], v[1]); w.y = cvt_pk_bf16(v[2], v[3]); return w; }
__device__ __forceinline__ float sigmoidf(float x) { return __builtin_amdgcn_rcpf(1.f + __expf(-x)); }
__device__ __forceinline__ f32x4 sigmoid4(f32x4 v) { return (f32x4){sigmoidf(v[0]), sigmoidf(v[1]), sigmoidf(v[2]), sigmoidf(v[3])}; }
__device__ __forceinline__ float wave_sum(float v) {
#pragma unroll
    for (int o = 1; o < 64; o <<= 1) v += __shfl_xor(v, o);
    return v;
}
__device__ __forceinline__ int crow(int r, int hi) { return (r & 3) + 8 * (r >> 2) + 4 * hi; }
__device__ __forceinline__ float dpp_ror1(float v) { return __builtin_bit_cast(float, __builtin_amdgcn_update_dpp(0, __builtin_bit_cast(int, v), 0x121, 0xf, 0xf, false)); }
__device__ __forceinline__ float dpp_ror15(float v) { return __builtin_bit_cast(float, __builtin_amdgcn_update_dpp(0, __builtin_bit_cast(int, v), 0x12F, 0xf, 0xf, false)); }
__device__ __forceinline__ void sincos_rr(float x, float& s, float& c) {
    const float n = rintf(x * 0.15915494309189535f);
    float r = fmaf(-n, 6.2831854820251465f, x); r = fmaf(-n, -1.7484556000744883e-07f, r);
    s = __sinf(r); c = __cosf(r);
}

namespace pg8 {
constexpr int BM = 256, BK = 64, HALF = 128, HTB = HALF * BK * 2, NXCD = 8, WGM = 3;
__host__ __device__ __forceinline__ int lds_byte(int r, int c) { const int st = (r >> 4) * 2 + (c >> 5), rr = r & 15, cc = c & 31, ob = rr * 64 + cc * 2; return st * 1024 + (ob ^ (((ob >> 9) & 1) << 5)); }
__host__ __device__ __forceinline__ void stage_rc(int b, int& R, int& C) { const int st = b / 1024, sb = b % 1024, swz = sb ^ (((sb >> 9) & 1) << 5); R = (st >> 1) * 16 + swz / 64; C = (st & 1) * 32 + (swz % 64) / 2; }
struct Unit { int pm, pn, k0, nk, sp, nsp, slot; };
struct Gemm { const bf16_t* A; const bf16_t* Bt; int lda, ldb; float* part; unsigned* cnt; };
struct StaticOrder {
    int nM, nN, nwg, G, c, nkt, rounds, R, nsp; bool qm;
    __device__ __forceinline__ void init(int nM_, int nN_, int G_, int c_, int nkt_, int max_sp) { nM = nM_; nN = nN_; nwg = nM * nN; G = G_; c = c_; nkt = nkt_; rounds = nwg / G; R = nwg - rounds * G; qm = false;
        nsp = 1; if (R > 0) { while (nsp * 2 * R <= G && nsp * 2 * R <= 256 && nsp * 2 <= max_sp && (nkt / (nsp * 2)) * (nsp * 2) == nkt && ((nkt / (nsp * 2)) & 1) == 0) nsp *= 2; } }
    __device__ __forceinline__ void map(int L, int& pm, int& pn) const {
        int wgid = L; { const int q = nwg / NXCD, r = nwg % NXCD, xcd = wgid % NXCD, off = wgid / NXCD; wgid = (xcd < r ? xcd * (q + 1) : r * (q + 1) + (xcd - r) * q) + off; }
        const int nig = WGM * nN, gid = wgid / nig, fm = gid * WGM, gsz = (nM - fm) < WGM ? (nM - fm) : WGM;
        pm = fm + ((wgid % nig) % gsz); pn = (wgid % nig) / gsz;
    }
    __device__ __forceinline__ bool next(int i, Unit& u) const {
        const bool quart = qm && R > 0 && R * 4 <= G;
        const int fan = quart ? 4 : nsp;
        const bool whole = i < rounds, part = (i == rounds) && (c < R * fan);
        const int j = c / fan, sub = part ? c - j * fan : 0, ns = (part && !quart) ? nsp : 1, nk = nkt / ns;
        int L = whole ? i * G + c : rounds * G + j; if (L >= nwg) L = nwg - 1;
        int pm, pn; map(L, pm, pn);
        u.pm = pm; u.pn = pn; u.k0 = quart ? 0 : sub * nk; u.nk = nk; u.sp = (part && quart) ? 1 + sub : (quart ? 0 : sub); u.nsp = ns; u.slot = (part && !quart) ? j : 0;
        return whole || part;
    }
};
template <class Epi, class Sched>
__device__ __forceinline__ void gemm_phase(LAS unsigned char* lds, const Gemm g, const Sched& S, const Epi& E) {
    const int tid = threadIdx.x, wid = __builtin_amdgcn_readfirstlane(tid >> 6), lane = tid & 63, wr = wid >> 2, wc = wid & 3, fr = lane & 15, fq = lane >> 4;
    unsigned voffA[2], voffB[2];
#pragma unroll
    for (int i = 0; i < 2; ++i) { int R, C; stage_rc(tid * 16 + i * 8192, R, C); voffA[i] = (unsigned)(R * g.lda + C) * 2u; voffB[i] = (unsigned)(R * g.ldb + C) * 2u; }
    const size_t kstep = (size_t)(BK * 2);
    const size_t hstepA = (size_t)HALF * g.lda * 2, hstepB = (size_t)HALF * g.ldb * 2;
    const unsigned ldsw = (unsigned)wid * 1024u;
    const int aoff = lds_byte(wr * 64 + fr, fq * 8), boff = lds_byte(wc * 32 + fr, fq * 8);
#define PG8_SA(b, h) (((b) * 2 + (h)) * HTB)
#define PG8_SB(b, h) ((4 + (b) * 2 + (h)) * HTB)
#define PG8_STAGE(bufoff, gbase, voff) do { _Pragma("unroll") for (int _i = 0; _i < 2; ++_i) \
        __builtin_amdgcn_global_load_lds((const unsigned*)((const char*)(gbase) + (voff)[_i]), (LAS unsigned*)(lds + (bufoff) + ldsw + _i * 8192), 16, 0, 0); } while (0)
#define PG8_LDA(dst, b, h) do { _Pragma("unroll") for (int m = 0; m < 4; ++m) _Pragma("unroll") for (int k = 0; k < 2; ++k) dst[m][k] = *(const LAS bf16x8*)(lds + PG8_SA(b, h) + aoff + m * 2048 + k * 1024); } while (0)
#define PG8_LDB(dst, b, h) do { _Pragma("unroll") for (int n = 0; n < 2; ++n) _Pragma("unroll") for (int k = 0; k < 2; ++k) dst[n][k] = *(const LAS bf16x8*)(lds + PG8_SB(b, h) + boff + n * 2048 + k * 1024); } while (0)
#define PG8_MMA(ai, bj, At, Bt) do { __builtin_amdgcn_s_setprio(1); _Pragma("unroll") for (int m = 0; m < 4; ++m) _Pragma("unroll") for (int n = 0; n < 2; ++n) _Pragma("unroll") for (int k = 0; k < 2; ++k) \
        acc[ai][bj][m][n] = __builtin_amdgcn_mfma_f32_16x16x32_bf16(Bt[n][k], At[m][k], acc[ai][bj][m][n], 0, 0, 0); __builtin_amdgcn_s_setprio(0); } while (0)
#define PG8_WAIT_V(n) asm volatile("s_waitcnt vmcnt(" #n ")" ::: "memory")
#define PG8_WAIT_L(n) asm volatile("s_waitcnt lgkmcnt(" #n ")" ::: "memory")
#define PG8_BAR __builtin_amdgcn_s_barrier()
#define PG8_SCHED __builtin_amdgcn_sched_barrier(0)
    Unit cur, nxt; int ui = 0;
    if (!S.next(0, cur)) return;
    f32x4 acc[2][2][4][2];
#pragma unroll
    for (int a = 0; a < 2; ++a)
#pragma unroll
        for (int b = 0; b < 2; ++b)
#pragma unroll
            for (int m = 0; m < 4; ++m)
#pragma unroll
                for (int n = 0; n < 2; ++n) acc[a][b][m][n] = (f32x4){0.f, 0.f, 0.f, 0.f};
    bf16x8 At[4][2], B0[2][2], B1[2][2];
    const char* cA = (const char*)g.A + E.aoff(cur, g.lda); const char* cB = (const char*)g.Bt + E.boff(cur, g.ldb);
    PG8_STAGE(PG8_SB(0, 0), cB, voffB); PG8_STAGE(PG8_SB(0, 1), cB + hstepB, voffB); PG8_STAGE(PG8_SA(0, 0), cA, voffA); PG8_STAGE(PG8_SA(0, 1), cA + hstepA, voffA);
    if (wr == 1) PG8_BAR;
    PG8_WAIT_V(2); PG8_BAR;
    PG8_STAGE(PG8_SB(1, 0), cB + kstep, voffB); PG8_STAGE(PG8_SA(1, 0), cA + kstep, voffA); PG8_STAGE(PG8_SB(1, 1), cB + hstepB + kstep, voffB);
    PG8_WAIT_V(6); PG8_BAR;
    for (;;) {
        const bool has_next = S.next(ui + 1, nxt);
        const char* nA = has_next ? (const char*)g.A + E.aoff(nxt, g.lda) : cA; const char* nB = has_next ? (const char*)g.Bt + E.boff(nxt, g.ldb) : cB;
        const int nt = cur.nk; const bool full = !(cur.nsp == 1 && cur.sp > 0);
        for (int t = 0; t < nt; t += 2) {
            const bool last = (t == nt - 2);
            const char* a1 = cA + (size_t)(t + 1) * kstep;
            const char* a2 = last ? nA : cA + (size_t)(t + 2) * kstep; const char* b2 = last ? nB : cB + (size_t)(t + 2) * kstep;
            const char* a3 = a2 + kstep; const char* b3 = b2 + kstep;
            PG8_LDB(B0, 0, 0); PG8_LDB(B1, 0, 1); PG8_SCHED; PG8_LDA(At, 0, 0); PG8_STAGE(PG8_SA(1, 1), a1 + hstepA, voffA);
            PG8_WAIT_V(8); PG8_WAIT_L(0); PG8_BAR; PG8_MMA(0, 0, At, B0); if (full) { PG8_MMA(0, 1, At, B1); } PG8_BAR; PG8_SCHED;
            PG8_LDA(At, 0, 1); PG8_STAGE(PG8_SB(0, 0), b2, voffB); PG8_STAGE(PG8_SB(0, 1), b2 + hstepB, voffB); PG8_STAGE(PG8_SA(0, 0), a2, voffA);
            PG8_WAIT_V(8); PG8_WAIT_L(0); PG8_BAR; if (full) { PG8_MMA(1, 0, At, B0); PG8_MMA(1, 1, At, B1); } PG8_BAR; PG8_SCHED;
            PG8_LDB(B0, 1, 0); PG8_LDB(B1, 1, 1); PG8_SCHED; PG8_LDA(At, 1, 0); PG8_STAGE(PG8_SA(0, 1), a2 + hstepA, voffA);
            PG8_WAIT_V(8); PG8_WAIT_L(0); PG8_BAR; PG8_MMA(0, 0, At, B0); if (full) { PG8_MMA(0, 1, At, B1); } PG8_BAR; PG8_SCHED;
            PG8_LDA(At, 1, 1); PG8_STAGE(PG8_SB(1, 0), b3, voffB); PG8_STAGE(PG8_SB(1, 1), b3 + hstepB, voffB); PG8_STAGE(PG8_SA(1, 0), a3, voffA);
            PG8_WAIT_V(8); PG8_WAIT_L(0); PG8_BAR; if (full) { PG8_MMA(1, 0, At, B0); PG8_MMA(1, 1, At, B1); } PG8_BAR; PG8_SCHED;
        }
        if (wr == 0) PG8_BAR;
        bool do_epi = true;
        if (cur.nsp > 1) {
            E.prescale(acc, cur, wr, wc, fr, fq);
            typedef float f32x2 __attribute__((ext_vector_type(2)));
            f32x4* pb16 = (f32x4*)g.part + (size_t)(cur.slot * cur.nsp) * 16384 + tid;
            { unsigned long long* pw = (unsigned long long*)(pb16 + (size_t)cur.sp * 16384);
#pragma unroll
              for (int a = 0; a < 2; ++a)
#pragma unroll
                for (int b = 0; b < 2; ++b)
#pragma unroll
                    for (int m = 0; m < 4; ++m)
#pragma unroll
                        for (int n = 0; n < 2; ++n) { const int i = ((a * 2 + b) * 4 + m) * 2 + n; const f32x4 v = acc[a][b][m][n];
                            __hip_atomic_store(pw + (size_t)i * 1024, __builtin_bit_cast(unsigned long long, (f32x2){v[0], v[1]}), __ATOMIC_RELAXED, __HIP_MEMORY_SCOPE_AGENT);
                            __hip_atomic_store(pw + (size_t)i * 1024 + 1, __builtin_bit_cast(unsigned long long, (f32x2){v[2], v[3]}), __ATOMIC_RELAXED, __HIP_MEMORY_SCOPE_AGENT); } }
            asm volatile("s_waitcnt vmcnt(0)" ::: "memory");
            __syncthreads();
            volatile LAS unsigned* fl = (volatile LAS unsigned*)(lds + LDS_EX + 16384 + 32);
            if (tid == 0) { const unsigned old = __hip_atomic_fetch_add(g.cnt + cur.slot, 1u, __ATOMIC_RELAXED, __HIP_MEMORY_SCOPE_AGENT);
                if (old == (unsigned)(cur.nsp - 1)) { __builtin_amdgcn_fence(__ATOMIC_ACQUIRE, "agent"); asm volatile("s_waitcnt vmcnt(0)" ::: "memory"); }
                fl[0] = old; }
            __syncthreads();
            do_epi = fl[0] == (unsigned)(cur.nsp - 1);
            if (do_epi) {
#pragma unroll
                for (int a = 0; a < 2; ++a)
#pragma unroll
                    for (int b = 0; b < 2; ++b)
#pragma unroll
                        for (int m = 0; m < 4; ++m)
#pragma unroll
                            for (int n = 0; n < 2; ++n) acc[a][b][m][n] = (f32x4){0.f, 0.f, 0.f, 0.f};
                for (int s = 0; s < cur.nsp; ++s) { const f32x4* pr = (const f32x4*)pb16 + (size_t)s * 16384;
#pragma unroll
                    for (int a = 0; a < 2; ++a) { f32x4 tv[2][4][2];
#pragma unroll
                        for (int b = 0; b < 2; ++b)
#pragma unroll
                            for (int m = 0; m < 4; ++m)
#pragma unroll
                                for (int n = 0; n < 2; ++n) tv[b][m][n] = pr[(((a * 2 + b) * 4 + m) * 2 + n) * 512];
#pragma unroll
                        for (int b = 0; b < 2; ++b)
#pragma unroll
                            for (int m = 0; m < 4; ++m)
#pragma unroll
                                for (int n = 0; n < 2; ++n) acc[a][b][m][n] += tv[b][m][n];
                        asm volatile("" ::: "memory"); } }
            }
        }
        if (do_epi) E(acc, cur, wr, wc, fr, fq, lds, ui & 1);
        if (!has_next) break;
#pragma unroll
        for (int a = 0; a < 2; ++a)
#pragma unroll
            for (int b = 0; b < 2; ++b)
#pragma unroll
                for (int m = 0; m < 4; ++m)
#pragma unroll
                    for (int n = 0; n < 2; ++n) acc[a][b][m][n] = (f32x4){0.f, 0.f, 0.f, 0.f};
        cur = nxt; cA = nA; cB = nB; ++ui;
        if (wr == 1) PG8_BAR;
    }
    PG8_WAIT_V(0);
    PG8_BAR;
#undef PG8_SA
#undef PG8_SB
#undef PG8_STAGE
#undef PG8_LDA
#undef PG8_LDB
#undef PG8_MMA
#undef PG8_WAIT_V
#undef PG8_WAIT_L
#undef PG8_BAR
#undef PG8_SCHED
}
}
using pg8::Unit;
#define EPI_FENCE() asm volatile("" ::: "memory")

struct EpiWin {
    bf16_t *U, *Q, *Kb, *Vb, *GS, *GA; float *outk, *outv; const float *ropec, *ropes;
    __device__ __forceinline__ int arow(int pm) const { return pm * 256; }
    __device__ __forceinline__ size_t aoff(const Unit& u, int lda) const { return (size_t)arow(u.pm) * lda * 2 + (size_t)u.k0 * 128; }
    __device__ __forceinline__ size_t boff(const Unit& u, int ldb) const { return (size_t)u.pn * 256 * ldb * 2 + (size_t)u.k0 * 128; }
    __device__ __forceinline__ void prescale(f32x4 (&acc)[2][2][4][2], const Unit& u, int wr, int wc, int fr, int fq) const {}
    __device__ __forceinline__ void operator()(f32x4 (&acc)[2][2][4][2], const Unit& u, int wr, int wc, int fr, int fq, LAS unsigned char* lds, int par) const {
        const int pn = u.pn; const int rowb = u.pm * 256 + wr * 64 + fr;
        if (pn < 4 || pn >= 10) {
            bf16_t* dst; int ld, cb; bool sig;
            if (pn < 4) { dst = U; ld = 1024; cb = pn * 256; sig = false; }
            else if (pn < 18) { dst = GS; ld = 2048; cb = (pn - 10) * 256; sig = true; }
            else { dst = GA; ld = 2048; cb = (pn - 18) * 256; sig = true; }
#pragma unroll
            for (int ai = 0; ai < 2; ++ai)
#pragma unroll
                for (int m = 0; m < 4; ++m) { bf16_t* rp = dst + (size_t)(rowb + 128 * ai + 16 * m) * ld + cb + 32 * wc + 4 * fq;
#pragma unroll
                    for (int bj = 0; bj < 2; ++bj)
#pragma unroll
                        for (int n = 0; n < 2; ++n) { f32x4 v = acc[ai][bj][m][n]; if (sig) v = sigmoid4(v); *(u32x2*)(rp + 128 * bj + 16 * n) = pack4(v); } }
        } else if (pn == 9) {
            const bool prm = u.pm < 32;
#pragma unroll
            for (int ai = 0; ai < 2; ++ai)
#pragma unroll
                for (int m = 0; m < 4; ++m) { const size_t off = (size_t)(rowb + 128 * ai + 16 * m) * 256 + 32 * wc + 4 * fq;
#pragma unroll
                    for (int bj = 0; bj < 2; ++bj)
#pragma unroll
                        for (int n = 0; n < 2; ++n) { const f32x4 v = acc[ai][bj][m][n]; *(u32x2*)(Vb + off + 128 * bj + 16 * n) = pack4(v); if (prm) *(f32x4*)(outv + off + 128 * bj + 16 * n) = v; } }
        } else {
            const bool isq = pn < 8, lat = u.pm >= 32; const int half = wc >> 1, f0 = (wc & 1) * 16 + 4 * fq, d1 = half * 64 + f0;
#pragma unroll
            for (int ai = 0; ai < 2; ++ai)
#pragma unroll
                for (int m = 0; m < 4; ++m) { const int row = rowb + 128 * ai + 16 * m;
                    f32x4 cs = (f32x4){1.f, 1.f, 1.f, 1.f}, sn = (f32x4){0.f, 0.f, 0.f, 0.f};
                    if (lat) { const int tl = (row - NPROMPT) & 1023; const int pr = half ? (tl & 63) : (tl >> 6); cs = *(const f32x4*)(ropec + pr * 32 + f0); sn = *(const f32x4*)(ropes + pr * 32 + f0); }
#pragma unroll
                    for (int bj = 0; bj < 2; ++bj) { const f32x4 x1 = acc[ai][bj][m][0], x2 = acc[ai][bj][m][1];
                        f32x4 o1 = x1 * cs - x2 * sn, o2 = x1 * sn + x2 * cs;
                        if (isq) { o1 = o1 * QSCALE; o2 = o2 * QSCALE; bf16_t* qp = Q + (size_t)row * 1024 + (pn - 4) * 256 + bj * 128 + d1; *(u32x2*)qp = pack4(o1); *(u32x2*)(qp + 32) = pack4(o2); }
                        else { const size_t off = (size_t)row * 256 + bj * 128 + d1; *(u32x2*)(Kb + off) = pack4(o1); *(u32x2*)(Kb + off + 32) = pack4(o2);
                            if (!lat) { *(f32x4*)(outk + off) = o1; *(f32x4*)(outk + off + 32) = o2; } } } }
        }
    }
};
struct WinOrder {
    int G, c;
    __device__ __forceinline__ bool next(int i, Unit& u) const {
        const int nwg = 1024; int L = i * G + c; const bool ok = L < nwg; if (!ok) L = nwg - 1;
        int wgid = L; { const int q = nwg / 8, xcd = wgid % 8, off = wgid / 8; wgid = xcd * q + off; }
        int pm, pn;
        if (wgid < 988) { constexpr int GW = 2; const int nig = GW * 26, gid = wgid / nig, fm = gid * GW, gsz = (38 - fm) < GW ? (38 - fm) : GW; pm = fm + ((wgid % nig) % gsz); pn = (wgid % nig) / gsz; }
        else { const int r = wgid - 988; pm = 38 + r / 18; pn = r % 18; }
        u.pm = pm; u.pn = pn; u.k0 = 0; u.nk = 32; u.sp = 0; u.nsp = 1; u.slot = 0; return ok;
    }
};
struct OneUnit {
    int pm, pn, nk;
    __device__ __forceinline__ bool next(int i, Unit& u) const { u.pm = pm; u.pn = pn; u.k0 = 0; u.nk = nk; u.sp = 0; u.nsp = 1; u.slot = 0; return i == 0; }
};
__device__ __forceinline__ void win_unit(LAS unsigned char* lds, const pg8::Gemm& g, const EpiWin& E, int t) { OneUnit S1; S1.pm = 38 + (t >> 3); S1.pn = 18 + (t & 7); S1.nk = 32; pg8::gemm_phase(lds, g, S1, E); }
struct EpiGlu {
    const bf16_t* Z; bf16_t* ZO;
    __device__ __forceinline__ int arow(int pm) const { return pm * 256; }
    __device__ __forceinline__ size_t aoff(const Unit& u, int lda) const { return (size_t)arow(u.pm) * lda * 2 + (size_t)u.k0 * 128; }
    __device__ __forceinline__ size_t boff(const Unit& u, int ldb) const { return (size_t)u.pn * 256 * ldb * 2 + (size_t)u.k0 * 128; }
    __device__ __forceinline__ void prescale(f32x4 (&acc)[2][2][4][2], const Unit& u, int wr, int wc, int fr, int fq) const {}
    __device__ __forceinline__ void operator()(f32x4 (&acc)[2][2][4][2], const Unit& u, int wr, int wc, int fr, int fq, LAS unsigned char* lds, int par) const {
        const int rowb = u.pm * 256 + wr * 64 + fr, cb = u.pn * 256 + 32 * wc + 4 * fq;
#pragma unroll
        for (int ai = 0; ai < 2; ++ai)
#pragma unroll
            for (int m = 0; m < 4; ++m) { const int row = rowb + 128 * ai + 16 * m;
#pragma unroll
                for (int bj = 0; bj < 2; ++bj)
#pragma unroll
                    for (int n = 0; n < 2; ++n) { const int col = cb + 128 * bj + 16 * n; const f32x4 z = unpack4(*(const u32x2*)(Z + (size_t)row * 1024 + col));
                        *(u32x2*)(ZO + (size_t)row * 2048 + col) = pack4(z * sigmoid4(acc[ai][bj][m][n])); }
                EPI_FENCE(); }
    }
};
struct EpiMerged {
    const bf16_t *GS, *GA; bf16_t* MG;
    __device__ __forceinline__ size_t aoff(const Unit& u, int lda) const { return ((size_t)u.pm * 256 + (u.sp > 0 ? ((u.sp - 1) >> 1) * 128 : 0)) * lda * 2 + (size_t)u.k0 * 128; }
    __device__ __forceinline__ size_t boff(const Unit& u, int ldb) const { return ((size_t)(u.pn >> 1) * 256 + (u.sp > 0 ? ((u.sp - 1) & 1) * 128 : 0)) * ldb * 2 + (size_t)u.k0 * 128; }
    __device__ __forceinline__ void prescale(f32x4 (&acc)[2][2][4][2], const Unit& u, int wr, int wc, int fr, int fq) const {}
    __device__ __forceinline__ void operator()(f32x4 (&acc)[2][2][4][2], const Unit& u, int wr, int wc, int fr, int fq, LAS unsigned char* lds, int par) const {
        const int seg = u.pn & 1; const bool quart = u.sp > 0; const int qr = quart ? ((u.sp - 1) >> 1) * 128 : 0, qc = quart ? ((u.sp - 1) & 1) * 128 : 0;
        const int rowb = u.pm * 256 + qr + wr * 64 + fr, cb = (u.pn >> 1) * 256 + qc + 32 * wc + 4 * fq; const bf16_t* gp = GS + (size_t)seg * (size_t)(20 * MiB);
#pragma unroll
        for (int ai = 0; ai < 2; ++ai)
#pragma unroll
            for (int m = 0; m < 4; ++m) { const size_t ro = (size_t)(rowb + 128 * ai + 16 * m) * 2048 + cb;
                if (quart && ai) continue;
#pragma unroll
                for (int bj = 0; bj < 2; ++bj) { if (quart && bj) continue;
#pragma unroll
                    for (int n = 0; n < 2; ++n) { f32x4 v = acc[ai][bj][m][n] * unpack4(*(const u32x2*)(gp + ro + 128 * bj + 16 * n));
                        if (seg) v += unpack4(*(const u32x2*)(MG + ro + 128 * bj + 16 * n));
                        *(u32x2*)(MG + ro + 128 * bj + 16 * n) = pack4(v); } }
                EPI_FENCE(); }
    }
};
static_assert(WS_GA - WS_GS == 40 * MiB, "EpiMerged addresses GA as GS + 20 Mi elements");
struct PairOrder {
    pg8::StaticOrder S;
    __device__ __forceinline__ bool next(int i, Unit& u) const {
        const int r2 = 2 * S.rounds; const bool whole = i < r2; const int i2 = i - r2;
        const bool quart = S.qm && S.R > 0 && S.R * 4 <= S.G; const int fan = quart ? 4 : 1;
        const bool part = !whole && i2 < 2 && S.c < S.R * fan;
        const int j = S.c / fan, q = S.c - j * fan; const int seg = (whole ? i : i2) & 1;
        int L = whole ? (i >> 1) * S.G + S.c : S.rounds * S.G + j; if (L >= S.nwg) L = S.nwg - 1;
        int pm, pn; S.map(L, pm, pn);
        u.pm = pm; u.pn = pn * 2 + seg; u.k0 = 16 * seg; u.nk = 16; u.sp = (part && quart) ? 1 + q : 0; u.nsp = 1; u.slot = 0;
        return whole || part;
    }
};
template <bool WRITE_XG> struct EpiRes {
    const float *xp, *xs; const float* xin; bool from_inputs; float* out; const float* mod; int gate_off; const float* G2; bf16_t* XG; float* rs; float* part;
    __device__ __forceinline__ int arow(int pm) const { return pm * 256; }
    __device__ __forceinline__ size_t aoff(const Unit& u, int lda) const { return ((size_t)arow(u.pm) + (u.sp > 0 ? ((u.sp - 1) >> 1) * 128 : 0)) * lda * 2 + (size_t)u.k0 * 128; }
    __device__ __forceinline__ size_t boff(const Unit& u, int ldb) const { return ((size_t)u.pn * 256 + (u.sp > 0 ? ((u.sp - 1) & 1) * 128 : 0)) * ldb * 2 + (size_t)u.k0 * 128; }
    __device__ __forceinline__ void prescale(f32x4 (&acc)[2][2][4][2], const Unit& u, int wr, int wc, int fr, int fq) const {}
    __device__ __forceinline__ void operator()(f32x4 (&acc)[2][2][4][2], const Unit& u, int wr, int wc, int fr, int fq, LAS unsigned char* lds, int par) const {
        const bool quart = u.sp > 0; const int qr = quart ? ((u.sp - 1) >> 1) * 128 : 0, qc = quart ? ((u.sp - 1) & 1) * 128 : 0;
        const int rowb = u.pm * 256 + qr + wr * 64 + fr, cb = u.pn * 256 + qc + 32 * wc + 4 * fq;
        const int ci = u.pm < 32 ? 0 : 1 + ((u.pm - 32) >> 2);
        const float* gp = mod + ci * 12288 + gate_off + cb; const float* g2p = G2 + ci * 2048 + cb;
        if (!WRITE_XG && u.slot > 0) {
            float* pp = part + (size_t)(u.slot - 1) * (2048 * 2048) + (size_t)(rowb - NPROMPT) * 2048 + cb;
#pragma unroll
            for (int ai = 0; ai < 2; ++ai)
#pragma unroll
                for (int m = 0; m < 4; ++m) {
#pragma unroll
                    for (int bj = 0; bj < 2; ++bj)
#pragma unroll
                        for (int n = 0; n < 2; ++n) *(f32x4*)(pp + (size_t)(128 * ai + 16 * m) * 2048 + 128 * bj + 16 * n) = acc[ai][bj][m][n] * *(const f32x4*)(gp + 128 * bj + 16 * n);
                    EPI_FENCE(); }
            return;
        }
        f32x4 gt[2][2], g2[2][2];
#pragma unroll
        for (int bj = 0; bj < 2; ++bj)
#pragma unroll
            for (int n = 0; n < 2; ++n) { gt[bj][n] = *(const f32x4*)(gp + 128 * bj + 16 * n); if (WRITE_XG) g2[bj][n] = *(const f32x4*)(g2p + 128 * bj + 16 * n); }
#pragma unroll
        for (int ai = 0; ai < 2; ++ai)
#pragma unroll
            for (int m = 0; m < 4; ++m) { const int row = rowb + 128 * ai + 16 * m; const size_t ro = (size_t)row * 2048 + cb;
                if (quart && ai) continue;
                const float* xr = from_inputs ? (row < NPROMPT ? xp + ro : xs + (ro - (size_t)NPROMPT * 2048)) : xin + ro;
                float ss = 0.f;
#pragma unroll
                for (int bj = 0; bj < 2; ++bj)
#pragma unroll
                    for (int n = 0; n < 2; ++n) { if (quart && bj) continue; const f32x4 xv = *(const f32x4*)(xr + 128 * bj + 16 * n); const f32x4 o = xv + gt[bj][n] * acc[ai][bj][m][n];
                        *(f32x4*)(out + ro + 128 * bj + 16 * n) = o; ss += (o[0] * o[0] + o[1] * o[1]) + (o[2] * o[2] + o[3] * o[3]);
                        if (WRITE_XG) *(u32x2*)(XG + ro + 128 * bj + 16 * n) = pack4(o * g2[bj][n]); }
                ss += __shfl_xor(ss, 16); ss += __shfl_xor(ss, 32);
                if (fq == 0) unsafeAtomicAdd(rs + row, ss);
                EPI_FENCE(); }
    }
};
struct EpiDown {
    float* out; const float* mod; float* rs; float* part; const float* fg; float* xch; unsigned* pcnt; bool fuse;
    __device__ __forceinline__ int arow(int pm) const { return pm * 256; }
    __device__ __forceinline__ size_t aoff(const Unit& u, int lda) const { return (size_t)arow(u.pm) * lda * 2 + (size_t)u.k0 * 128; }
    __device__ __forceinline__ size_t boff(const Unit& u, int ldb) const { return (size_t)u.pn * 256 * ldb * 2 + (size_t)u.k0 * 128; }
    __device__ __forceinline__ void prescale(f32x4 (&acc)[2][2][4][2], const Unit& u, int wr, int wc, int fr, int fq) const {}
    __device__ __forceinline__ void operator()(f32x4 (&acc)[2][2][4][2], const Unit& u, int wr, int wc, int fr, int fq, LAS unsigned char* lds, int par) const {
        const int tid = threadIdx.x;
        const int rowb = u.pm * 256 + wr * 64 + fr, cb = u.pn * 256 + 32 * wc + 4 * fq;
        const int ci = u.pm < 32 ? 0 : 1 + ((u.pm - 32) >> 2);
        const float* gp = mod + ci * 12288 + 5 * 2048 + cb;
        if (u.slot > 0) {
            float* pp = part + (size_t)(u.slot - 1) * (2048 * 2048) + (size_t)(rowb - NPROMPT) * 2048 + cb;
#pragma unroll
            for (int ai = 0; ai < 2; ++ai)
#pragma unroll
                for (int m = 0; m < 4; ++m) {
#pragma unroll
                    for (int bj = 0; bj < 2; ++bj)
#pragma unroll
                        for (int n = 0; n < 2; ++n) *(f32x4*)(pp + (size_t)(128 * ai + 16 * m) * 2048 + 128 * bj + 16 * n) = acc[ai][bj][m][n] * *(const f32x4*)(gp + 128 * bj + 16 * n);
                    EPI_FENCE(); }
            return;
        }
        float* ob = out + (size_t)u.pm * 256 * 2048 + u.pn * 256; const int lo_ = (wr * 64 + fr) * 2048 + 32 * wc + 4 * fq;
        f32x4 gt[2][2];
#pragma unroll
        for (int bj = 0; bj < 2; ++bj)
#pragma unroll
            for (int n = 0; n < 2; ++n) gt[bj][n] = *(const f32x4*)(gp + 128 * bj + 16 * n);
        float ssr[2][4];
#pragma unroll
        for (int ai = 0; ai < 2; ++ai)
#pragma unroll
            for (int m = 0; m < 4; ++m) { const int row = rowb + 128 * ai + 16 * m; const int ro = lo_ + (128 * ai + 16 * m) * 2048;
                float ss = 0.f;
#pragma unroll
                for (int bj = 0; bj < 2; ++bj)
#pragma unroll
                    for (int n = 0; n < 2; ++n) { const f32x4 xv = *(const f32x4*)(ob + (ro + 128 * bj + 16 * n)); const f32x4 o = xv + gt[bj][n] * acc[ai][bj][m][n];
                        ss += (o[0] * o[0] + o[1] * o[1]) + (o[2] * o[2] + o[3] * o[3]);
                        *(f32x4*)(ob + (ro + 128 * bj + 16 * n)) = o; }
                ss += __shfl_xor(ss, 16); ss += __shfl_xor(ss, 32);
                if (!fuse) { if (fq == 0) unsafeAtomicAdd(rs + row, ss); }
                ssr[ai][m] = ss;
                EPI_FENCE(); }
        if (!fuse) return;
        LAS float* P = (LAS float*)(lds + LDS_EX); LAS float* S = P + 1024; volatile LAS unsigned* fl = (volatile LAS unsigned*)(lds + LDS_EX + 8192);
#pragma unroll
        for (int ai = 0; ai < 2; ++ai)
#pragma unroll
            for (int m = 0; m < 4; ++m) if (fq == 0) P[(128 * ai + 64 * wr + 16 * m + fr) * 4 + wc] = ssr[ai][m];
        asm volatile("s_waitcnt lgkmcnt(0)" ::: "memory"); __syncthreads();
        if (tid < 256) { const float s = (P[tid * 4 + 0] + P[tid * 4 + 1]) + (P[tid * 4 + 2] + P[tid * 4 + 3]);
            __hip_atomic_store(xch + (size_t)(u.pm * 256 + tid) * 8 + u.pn, s, __ATOMIC_RELAXED, __HIP_MEMORY_SCOPE_AGENT); }
        asm volatile("s_waitcnt vmcnt(0)" ::: "memory"); __syncthreads();
        if (tid == 0) { unsigned* pc = pcnt + 64 * u.pm; __hip_atomic_fetch_add(pc, 1u, __ATOMIC_RELAXED, __HIP_MEMORY_SCOPE_AGENT);
            unsigned sp_ = 0; while (__hip_atomic_load(pc, __ATOMIC_RELAXED, __HIP_MEMORY_SCOPE_AGENT) < 8u) { __builtin_amdgcn_s_sleep(2); if (++sp_ > (1u << 22)) break; }
            __builtin_amdgcn_fence(__ATOMIC_ACQUIRE, "agent"); asm volatile("s_waitcnt vmcnt(0)" ::: "memory"); fl[0] = 1u; }
        __syncthreads();
        if (tid < 256) { const float* xr = xch + (size_t)(u.pm * 256 + tid) * 8; float tot = 0.f;
#pragma unroll
            for (int j = 0; j < 8; ++j) tot += __hip_atomic_load(xr + j, __ATOMIC_RELAXED, __HIP_MEMORY_SCOPE_AGENT);
            S[tid] = rsqrtf(tot * (1.f / DM) + EPS); }
        asm volatile("s_waitcnt lgkmcnt(0)" ::: "memory"); __syncthreads();
        f32x4 fgv[2][2];
#pragma unroll
        for (int bj = 0; bj < 2; ++bj)
#pragma unroll
            for (int n = 0; n < 2; ++n) fgv[bj][n] = *(const f32x4*)(fg + cb + 128 * bj + 16 * n);
#pragma unroll
        for (int ai = 0; ai < 2; ++ai)
#pragma unroll
            for (int m = 0; m < 4; ++m) { const int rl = 128 * ai + 64 * wr + 16 * m + fr; const float r = S[rl]; const int ro = lo_ + (128 * ai + 16 * m) * 2048;
#pragma unroll
                for (int bj = 0; bj < 2; ++bj)
#pragma unroll
                    for (int n = 0; n < 2; ++n) { const f32x4 x2 = *(const f32x4*)(ob + (ro + 128 * bj + 16 * n)); *(f32x4*)(ob + (ro + 128 * bj + 16 * n)) = x2 * r * fgv[bj][n]; }
                EPI_FENCE(); }
    }
};
struct DownOrder {
    pg8::StaticOrder S; bool split;
    __device__ __forceinline__ bool next(int i, Unit& u) const {
        if (!split) return S.next(i, u);
        const int c = S.c; const bool r0 = i == 0, ok = i < 2;
        const int j = c >> 2, sp = c & 3;
        u.pm = r0 ? (c >> 6) * 8 + (c & 7) : 32 + (j & 7); u.pn = r0 ? (c & 63) >> 3 : j >> 3;
        u.k0 = r0 ? 0 : sp * 22; u.nk = r0 ? 88 : 22; u.sp = 0; u.nsp = 1; u.slot = r0 ? 0 : 1 + sp;
        return ok;
    }
};
struct EpiUp {
    const float *rs1, *shv2, *convw, *convb; bf16_t* ACT; float *hbp, *hbh;
    __device__ __forceinline__ int arow(int pm) const { return pm * 256; }
    __device__ __forceinline__ size_t aoff(const Unit& u, int lda) const { return (size_t)arow(u.pm) * lda * 2 + (size_t)u.k0 * 128; }
    __device__ __forceinline__ size_t boff(const Unit& u, int ldb) const { return (size_t)u.pn * 256 * ldb * 2 + (size_t)u.k0 * 128; }
    __device__ __forceinline__ void prescale(f32x4 (&acc)[2][2][4][2], const Unit& u, int wr, int wc, int fr, int fq) const {}
    __device__ __forceinline__ void operator()(f32x4 (&acc)[2][2][4][2], const Unit& u, int wr, int wc, int fr, int fq, LAS unsigned char* lds, int par) const {
        const int pm = u.pm, pn = u.pn; const int ar = arow(pm);
        int seq_lo, seq_hi, ci; bool d0 = false, d255 = false;
        if (pm < 32) { seq_lo = ar; seq_hi = ar + 256; ci = 0; }
        else { const int lb = (pm - 32) >> 2, j = (pm - 32) & 3; seq_lo = NPROMPT + 1024 * lb; seq_hi = seq_lo + 1024; ci = 1 + lb; d0 = j != 0; d255 = j != 3; }
        const int st_lo = 0, st_hi = 255;
        const int jj0 = 32 * wc + 4 * fq;
        const int ca0 = 128 * pn + jj0;
        f32x4 sh[2][2];
#pragma unroll
        for (int bj = 0; bj < 2; ++bj)
#pragma unroll
            for (int n = 0; n < 2; ++n) sh[bj][n] = *(const f32x4*)(shv2 + ci * NUP + bj * DFF + ca0 + 16 * n);
#pragma unroll
        for (int ai = 0; ai < 2; ++ai)
#pragma unroll
            for (int m = 0; m < 4; ++m) { const int row = ar + 128 * ai + 64 * wr + 16 * m + fr; const bool ok = row >= seq_lo && row < seq_hi;
                const float rstd = ok ? rsqrtf(rs1[row] * (1.f / DM) + EPS) : 0.f;
#pragma unroll
                for (int bj = 0; bj < 2; ++bj)
#pragma unroll
                    for (int n = 0; n < 2; ++n) { f32x4 h = acc[ai][bj][m][n] * rstd + sh[bj][n]; if (!ok) h = (f32x4){0.f, 0.f, 0.f, 0.f}; acc[ai][bj][m][n] = h; } }
        LAS float* ex = (LAS float*)(lds + LDS_EX + par * 8192);
#pragma unroll
        for (int ai = 0; ai < 2; ++ai)
#pragma unroll
            for (int bj = 0; bj < 2; ++bj)
#pragma unroll
                for (int n = 0; n < 2; ++n) { const int colx = 128 * bj + jj0 + 16 * n;
                    if (fr == 0) *(LAS f32x4*)(ex + ((ai * 2 + wr) * 2 + 0) * 256 + colx) = acc[ai][bj][0][n];
                    if (fr == 15) *(LAS f32x4*)(ex + ((ai * 2 + wr) * 2 + 1) * 256 + colx) = acc[ai][bj][3][n]; }
        asm volatile("s_waitcnt lgkmcnt(0)" ::: "memory"); __builtin_amdgcn_s_barrier(); asm volatile("" ::: "memory");
#pragma unroll
        for (int n = 0; n < 2; ++n) {
            f32x4 w0[2], w1[2], w2[2], cbv[2];
#pragma unroll
            for (int bj = 0; bj < 2; ++bj) { const int oc = bj * DFF + ca0 + 16 * n; w0[bj] = *(const f32x4*)(convw + oc); w1[bj] = *(const f32x4*)(convw + NUP + oc); w2[bj] = *(const f32x4*)(convw + 2 * NUP + oc); cbv[bj] = *(const f32x4*)(convb + oc); }
#pragma unroll
            for (int ai = 0; ai < 2; ++ai) {
                const int sidx = ai * 2 + wr;
#pragma unroll
                for (int m = 0; m < 4; ++m) { const int il = 128 * ai + 64 * wr + 16 * m + fr; const int row = ar + il;
                    const bool st = il >= st_lo && il <= st_hi && row < seq_hi;
                    f32x4 cv[2];
#pragma unroll
                    for (int bj = 0; bj < 2; ++bj) { const int colx = 128 * bj + jj0 + 16 * n;
                        const f32x4 hc = acc[ai][bj][m][n]; f32x4 up, dn;
                        if (m > 0) { const f32x4 hp = acc[ai][bj][m > 0 ? m - 1 : 0][n];
#pragma unroll
                            for (int e = 0; e < 4; ++e) up[e] = dpp_ror1(fr == 15 ? hp[e] : hc[e]); }
                        else { f32x4 edge = (f32x4){0.f, 0.f, 0.f, 0.f}; if (sidx > 0) edge = *(const LAS f32x4*)(ex + ((sidx - 1) * 2 + 1) * 256 + colx);
#pragma unroll
                            for (int e = 0; e < 4; ++e) { const float a_ = dpp_ror1(hc[e]); up[e] = fr == 0 ? edge[e] : a_; } }
                        if (m < 3) { const f32x4 hn = acc[ai][bj][m < 3 ? m + 1 : 3][n];
#pragma unroll
                            for (int e = 0; e < 4; ++e) dn[e] = dpp_ror15(fr == 0 ? hn[e] : hc[e]); }
                        else { f32x4 edge = (f32x4){0.f, 0.f, 0.f, 0.f}; if (sidx < 3) edge = *(const LAS f32x4*)(ex + ((sidx + 1) * 2 + 0) * 256 + colx);
#pragma unroll
                            for (int e = 0; e < 4; ++e) { const float a_ = dpp_ror15(hc[e]); dn[e] = fr == 15 ? edge[e] : a_; } }
                        cv[bj] = up * w0[bj] + hc * w1[bj] + dn * w2[bj] + cbv[bj]; }
                    const bool def = (il == 0 && d0) || (il == 255 && d255);
                    if (st && !def) { const f32x4 a_ = cv[0], b_ = cv[1]; f32x4 o;
#pragma unroll
                        for (int e = 0; e < 4; ++e) o[e] = a_[e] * sigmoidf(a_[e]) * b_[e];
                        *(u32x2*)(ACT + (size_t)row * DFF + ca0 + 16 * n) = pack4(o); }
                    if (def) { const size_t hb = (size_t)((pm - 32) * 2 + (il == 255 ? 1 : 0)) * NUP + ca0 + 16 * n;
                        *(f32x4*)(hbp + hb) = cv[0]; *(f32x4*)(hbp + hb + DFF) = cv[1]; *(f32x4*)(hbh + hb) = acc[ai][0][m][n]; *(f32x4*)(hbh + hb + DFF) = acc[ai][1][m][n]; }
                    EPI_FENCE(); }
            }
        }
    }
};

__device__ __forceinline__ int rowmap_win(int n) { if (n >= 1024 && n < 2304) { const int d = n & 127; return (n & ~127) + 32 * (2 * (d >> 6) + ((d >> 4) & 1)) + 16 * ((d >> 5) & 1) + (d & 15); } return n; }
__device__ __forceinline__ int rowmap_up(int n) { return n < DFF ? ((n >> 7) * 256 + (n & 127)) : (((n - DFF) >> 7) * 256 + 128 + ((n - DFF) & 127)); }
template <int MODE> __device__ __forceinline__ void transpose_item(const float* W, int N, bf16_t* WT, int ldk, int koff, LAS float* scr, int item, int lane, const float* sh2, float* shv) {
    const int nblk = N / 32, kb = item / nblk, nb = item % nblk, k0 = 64 * kb, n0 = 32 * nb;
    { float tv[32];
#pragma unroll
      for (int i = 0; i < 32; ++i) tv[i] = __builtin_nontemporal_load(W + (size_t)(k0 + 2 * i + (lane >> 5)) * N + n0 + (lane & 31));
#pragma unroll
      for (int i = 0; i < 32; ++i) scr[(2 * i + (lane >> 5)) * 33 + (lane & 31)] = tv[i]; }
    asm volatile("s_waitcnt lgkmcnt(0)" ::: "memory");
    const int c = lane & 7;
#pragma unroll
    for (int j = 0; j < 4; ++j) { const int n = (lane >> 3) + 8 * j; const LAS float* s = scr + (8 * c) * 33 + n;
        u32x4 o; o.x = cvt_pk_bf16(s[0 * 33], s[1 * 33]); o.y = cvt_pk_bf16(s[2 * 33], s[3 * 33]); o.z = cvt_pk_bf16(s[4 * 33], s[5 * 33]); o.w = cvt_pk_bf16(s[6 * 33], s[7 * 33]);
        const int ns = n0 + n; const int rdst = MODE == 1 ? rowmap_win(ns) : (MODE == 2 ? rowmap_up(ns) : ns);
        *(u32x4*)(WT + (size_t)rdst * ldk + koff + k0 + 8 * c) = o; }
    asm volatile("s_waitcnt lgkmcnt(0)" ::: "memory");
}
__device__ __forceinline__ void phase0(const Args& a, LAS unsigned char* lds) {
    const int tid = threadIdx.x;
    LAS float* sl = (LAS float*)lds;
    LAS float* red = (LAS float*)(lds + 24576);
    const float* c = a.in[6]; const float* cctx = a.in[7];
    for (int i = tid; i < 3 * 2048; i += 512) { const int ci = i >> 11, k = i & 2047; const float x = ci == 0 ? cctx[k] : c[(ci - 1) * 2048 + k]; sl[i] = x * sigmoidf(x); }
    __syncthreads();
    float* mod = (float*)(a.ws + WS_MOD); const float* wmod = a.in[10]; const float* bmod = a.in[11];
    const int cgp = tid & 127, rg = tid >> 7;
    for (int it = blockIdx.x; it < 768; it += gridDim.x) {
        const int nc = it % 24, ks = it / 24, n0 = nc * 512, k0 = ks * 64;
        f32x4 a0 = (f32x4){0.f, 0.f, 0.f, 0.f}, a1 = a0, a2 = a0;
        { f32x4 wv[16];
#pragma unroll
          for (int i = 0; i < 16; ++i) wv[i] = __builtin_nontemporal_load((const f32x4*)(wmod + (size_t)(k0 + rg + 4 * i) * 12288 + n0 + 4 * cgp));
#pragma unroll
          for (int i = 0; i < 16; ++i) { const int k = k0 + rg + 4 * i; a0 += wv[i] * sl[k]; a1 += wv[i] * sl[2048 + k]; a2 += wv[i] * sl[4096 + k]; } }
        *(LAS f32x4*)(red + (rg * 3 + 0) * 512 + 4 * cgp) = a0; *(LAS f32x4*)(red + (rg * 3 + 1) * 512 + 4 * cgp) = a1; *(LAS f32x4*)(red + (rg * 3 + 2) * 512 + 4 * cgp) = a2;
        __syncthreads();
#pragma unroll
        for (int ci = 0; ci < 3; ++ci) { float v = (red[(0 * 3 + ci) * 512 + tid] + red[(1 * 3 + ci) * 512 + tid]) + (red[(2 * 3 + ci) * 512 + tid] + red[(3 * 3 + ci) * 512 + tid]);
            if (ks == 0) v += bmod[n0 + tid]; unsafeAtomicAdd(mod + ci * 12288 + n0 + tid, v); }
        __syncthreads();
    }
    if (blockIdx.x == gridDim.x - 1) {
        float* rc = (float*)(a.ws + WS_ROPEC); float* rsn = (float*)(a.ws + WS_ROPES);
        for (int i = tid; i < 2048; i += 512) { const int p = i >> 5, f = i & 31; const float inv = exp2f(-(float)f * (13.287712379549449f / 32.f)); float s, cc; sincos_rr((float)p * inv, s, cc); rc[i] = cc; rsn[i] = s; }
    }
    __syncthreads();
    { const int lane = tid & 63, wave = __builtin_amdgcn_readfirstlane(tid >> 6); LAS float* scr = (LAS float*)(lds + wave * 8704); const int gw = blockIdx.x * 8 + wave, NGW = gridDim.x * 8;
    constexpr int I_UP = 32 * 352, I_WIN = 32 * 208;
    for (int it = gw; it < I_WIN + I_UP; it += NGW) {
        if (it < I_WIN) transpose_item<1>(a.in[12], INC, (bf16_t*)(a.ws + WS_WIN), 2048, 0, scr, it, lane, nullptr, nullptr);
        else transpose_item<2>(a.in[26], NUP, (bf16_t*)(a.ws + WS_WUP), LDWUP, 0, scr, it - I_WIN, lane, nullptr, nullptr);
    }
      const int gt = blockIdx.x * 512 + tid, NGT = gridDim.x * 512;
    { bf16_t* CK = (bf16_t*)(a.ws + WS_CK); bf16_t* CV = (bf16_t*)(a.ws + WS_CV);
      for (int i = gt; i < 32768; i += NGT) { const f32x4 kv = *(const f32x4*)(a.in[2] + 4 * i), vv = *(const f32x4*)(a.in[3] + 4 * i); *(u32x2*)(CK + 4 * i) = pack4(kv); *(u32x2*)(CV + 4 * i) = pack4(vv); } }
    }
}

__device__ __forceinline__ void phase1(const Args& a, LAS unsigned char* lds) {
    const int tid = threadIdx.x, lane = tid & 63, wave = __builtin_amdgcn_readfirstlane(tid >> 6);
    LAS float* scr = (LAS float*)(lds + wave * 8704);
    const int gw = blockIdx.x * 8 + wave, NGW = gridDim.x * 8;
    const float* mod = (const float*)(a.ws + WS_MOD);
    const float* g1 = a.in[8]; bf16_t* XM = (bf16_t*)(a.ws + WS_XM);
    for (int m0 = gw; m0 < MT; m0 += 2 * NGW) {
        f32x4 v[2][8]; float ss[2] = {0.f, 0.f};
#pragma unroll
        for (int q = 0; q < 2; ++q) { const int m = (m0 + q * NGW) < MT ? (m0 + q * NGW) : m0; const float* xr = m < NPROMPT ? a.in[0] + (size_t)m * DM : a.in[1] + (size_t)(m - NPROMPT) * DM;
#pragma unroll
            for (int j = 0; j < 8; ++j) v[q][j] = *(const f32x4*)(xr + 4 * lane + 256 * j); }
#pragma unroll
        for (int q = 0; q < 2; ++q) { const int m = m0 + q * NGW; if (m >= MT) continue; const int ci = m < NPROMPT ? 0 : 1 + ((m - NPROMPT) >> 10);
#pragma unroll
            for (int j = 0; j < 8; ++j) ss[q] += (v[q][j][0] * v[q][j][0] + v[q][j][1] * v[q][j][1]) + (v[q][j][2] * v[q][j][2] + v[q][j][3] * v[q][j][3]);
            const float rstd = rsqrtf(wave_sum(ss[q]) * (1.f / DM) + EPS);
#pragma unroll
            for (int j = 0; j < 8; ++j) { const int col = 4 * lane + 256 * j; const f32x4 g = *(const f32x4*)(g1 + col), sc = *(const f32x4*)(mod + ci * 12288 + 2048 + col), sh = *(const f32x4*)(mod + ci * 12288 + col);
                const f32x4 o = v[q][j] * rstd * g * (sc + 1.f) + sh; *(u32x2*)(XM + (size_t)m * DM + col) = pack4(o); } }
    }
    const int gt = blockIdx.x * 512 + tid, NGT = gridDim.x * 512;
    { float* G2 = (float*)(a.ws + WS_G2); const float* g2n = a.in[9];
      for (int i = gt; i < 3 * 2048; i += NGT) { const int ci = i >> 11, col = i & 2047; G2[i] = g2n[col] * (1.f + mod[ci * 12288 + 4 * 2048 + col]); } }
}

__device__ __forceinline__ void drain_transposes(const Args& a, LAS unsigned char* lds, int kind, int lo, int hi, unsigned* ctr) {
    const int lane = threadIdx.x & 63, wave = __builtin_amdgcn_readfirstlane(threadIdx.x >> 6);
    LAS float* scr = (LAS float*)(lds + wave * 8704);
    const float* mod = (const float*)(a.ws + WS_MOD);
    for (;;) {
        int it = 0; if (lane == 0) it = (int)atomicAdd(ctr, 1u); it = __builtin_amdgcn_readfirstlane(it) + lo;
        if (it >= hi) break;
        if (kind == 1) transpose_item<2>(a.in[26], NUP, (bf16_t*)(a.ws + WS_WUP), LDWUP, 0, scr, it, lane, mod + 3 * 2048, (float*)(a.ws + WS_SHV2));
        else if (kind == 2) transpose_item<0>(a.in[29], 2048, (bf16_t*)(a.ws + WS_WDN), DFF, 0, scr, it, lane, nullptr, nullptr);
        else { int r = it;
            if (r < 512) transpose_item<0>(a.in[21], 1024, (bf16_t*)(a.ws + WS_WGLU), 1024, 0, scr, r, lane, nullptr, nullptr);
            else if (r < 1536) transpose_item<0>(a.in[23], 2048, (bf16_t*)(a.ws + WS_WM), 2048, 0, scr, r - 512, lane, nullptr, nullptr);
            else if (r < 2560) transpose_item<0>(a.in[24], 2048, (bf16_t*)(a.ws + WS_WM), 2048, 1024, scr, r - 1536, lane, nullptr, nullptr);
            else transpose_item<0>(a.in[25], 2048, (bf16_t*)(a.ws + WS_WOUT), 2048, 0, scr, r - 2560, lane, nullptr, nullptr); }
    }
}

__device__ __forceinline__ void shv2_rows(const Args& a) {
    const int lane = threadIdx.x & 63, wave = __builtin_amdgcn_readfirstlane(threadIdx.x >> 6);
    const float* mod = (const float*)(a.ws + WS_MOD); float* shv = (float*)(a.ws + WS_SHV2);
    f32x4 sv[3][4][2];
#pragma unroll
    for (int ci = 0; ci < 3; ++ci)
#pragma unroll
        for (int j = 0; j < 4; ++j) { const int k = 8 * lane + 512 * j; sv[ci][j][0] = *(const f32x4*)(mod + ci * 12288 + 3 * 2048 + k); sv[ci][j][1] = *(const f32x4*)(mod + ci * 12288 + 3 * 2048 + k + 4); }
    const int nw = gridDim.x * 8;
    for (int n0 = blockIdx.x * 8 + wave; n0 < NUP; n0 += 3 * nw) {
        u32x4 w[3][4];
#pragma unroll
        for (int q = 0; q < 3; ++q) { const int n = n0 + q * nw; const int nc = n < NUP ? n : n0;
            const bf16_t* wr_ = (const bf16_t*)(a.ws + WS_WUP) + (size_t)rowmap_up(nc) * LDWUP + 8 * lane;
#pragma unroll
            for (int j = 0; j < 4; ++j) w[q][j] = *(const u32x4*)(wr_ + 512 * j); }
#pragma unroll
        for (int q = 0; q < 3; ++q) { const int n = n0 + q * nw; float v[3] = {0.f, 0.f, 0.f};
#pragma unroll
            for (int j = 0; j < 4; ++j) { const f32x4 wa = unpack4((u32x2){w[q][j].x, w[q][j].y}), wb = unpack4((u32x2){w[q][j].z, w[q][j].w});
#pragma unroll
                for (int ci = 0; ci < 3; ++ci) { const f32x4 sa = sv[ci][j][0], sb = sv[ci][j][1];
                    v[ci] += (wa[0] * sa[0] + wa[1] * sa[1]) + (wa[2] * sa[2] + wa[3] * sa[3]) + (wb[0] * sb[0] + wb[1] * sb[1]) + (wb[2] * sb[2] + wb[3] * sb[3]); } }
            const float v0 = wave_sum(v[0]), v1 = wave_sum(v[1]), v2 = wave_sum(v[2]);
            if (lane == 0 && n < NUP) { shv[n] = v0; shv[NUP + n] = v1; shv[2 * NUP + n] = v2; } }
    }
}

__device__ __forceinline__ void small_weight_item(const Args& a, LAS float* scr, int it, int lane) {
    if (it < 512) transpose_item<0>(a.in[21], 1024, (bf16_t*)(a.ws + WS_WGLU), 1024, 0, scr, it, lane, nullptr, nullptr);
    else if (it < 1536) transpose_item<0>(a.in[23], 2048, (bf16_t*)(a.ws + WS_WM), 2048, 0, scr, it - 512, lane, nullptr, nullptr);
    else if (it < 2560) transpose_item<0>(a.in[24], 2048, (bf16_t*)(a.ws + WS_WM), 2048, 1024, scr, it - 1536, lane, nullptr, nullptr);
    else transpose_item<0>(a.in[25], 2048, (bf16_t*)(a.ws + WS_WOUT), 2048, 0, scr, it - 2560, lane, nullptr, nullptr);
}

__device__ __forceinline__ void attn_unit(const Args& a, LAS unsigned char* lds, int idx) {
    const int tid = threadIdx.x, lane = tid & 63, w = __builtin_amdgcn_readfirstlane(tid >> 6), n = lane & 31, hi = lane >> 5;
    const bf16_t* Q = (const bf16_t*)(a.ws + WS_Q); const bf16_t* Kb = (const bf16_t*)(a.ws + WS_K); const bf16_t* Vb = (const bf16_t*)(a.ws + WS_V);
    const bf16_t* CK = (const bf16_t*)(a.ws + WS_CK); const bf16_t* CV = (const bf16_t*)(a.ws + WS_CV); bf16_t* ZO = (bf16_t*)(a.ws + WS_ZO);
    LAS unsigned char* Ks = lds; LAS unsigned char* Vt = lds + 17408; LAS float* wsf = (LAS float*)(lds + 35840 + w * 256);
    bool lat; int rb, kvh, qb, hp, lb;
    if (idx < 64) { lat = true; lb = idx >> 5; const int rest = idx & 31; kvh = rest >> 4; qb = (rest >> 1) & 7; hp = rest & 1; rb = NPROMPT + lb * 1024; }
    else { lat = false; const int j = idx - 64; lb = j >> 3; kvh = (j >> 2) & 1; qb = (j >> 1) & 1; hp = j & 1; rb = lb * 256; }
    const int head = kvh * 4 + hp * 2 + (w >> 2);
    const int qloc = qb * 128 + (w & 3) * 32;
    bf16x8 qf[8];
    { const bf16_t* qp = Q + (size_t)(rb + qloc + n) * 1024 + head * 128 + 8 * hi;
#pragma unroll
      for (int s = 0; s < 8; ++s) qf[s] = *(const bf16x8*)(qp + 16 * s); }
    float mrun = a.in[22][head] * LOG2E, l = hi == 0 ? 1.f : 0.f;
    f32x16 o[4];
#pragma unroll
    for (int d = 0; d < 4; ++d)
#pragma unroll
        for (int r = 0; r < 16; ++r) o[d][r] = 0.f;
    int kstart = 0, nloc = 4;
    if (lat) { kstart = (qb - 1) * 128; if (kstart < 0) kstart = 0; int kend = (qb + 2) * 128; if (kend > 1024) kend = 1024; nloc = (kend - kstart) >> 6; }
    const int nt = lat ? nloc + 4 : 4;
    const int qpos = qloc + n;
    const int skey = tid >> 4, schk = tid & 15;
    u32x4 kreg[2], vreg[2];
#define ATT_SRC(t, off) do { if (!lat) off = (size_t)(rb + 64 * (t)) * 256 + kvh * 128; else if ((t) < nloc) off = (size_t)(rb + kstart + 64 * (t)) * 256 + kvh * 128; else off = (size_t)(lb * 256 + 64 * ((t) - nloc)) * 256 + kvh * 128; } while (0)
#define ATT_ISSUE(t) do { size_t off_; ATT_SRC(t, off_); const bool ctx_ = lat && (t) >= nloc; const bf16_t* ks_ = (ctx_ ? CK : Kb) + off_; const bf16_t* vs_ = (ctx_ ? CV : Vb) + off_; \
        _Pragma("unroll") for (int i_ = 0; i_ < 2; ++i_) { kreg[i_] = *(const u32x4*)(ks_ + (size_t)(skey + 32 * i_) * 256 + schk * 8); vreg[i_] = *(const u32x4*)(vs_ + (size_t)(skey + 32 * i_) * 256 + schk * 8); } } while (0)
    ATT_ISSUE(0);
    for (int t = 0; t < nt; ++t) {
        const bool lmask = lat && t < nloc; const int kpos0 = kstart + 64 * t;
        __syncthreads();
#pragma unroll
        for (int i = 0; i < 2; ++i) { const int key = skey + 32 * i;
            *(LAS u32x4*)(Ks + key * 272 + schk * 16) = kreg[i];
            const u32x4 vv = vreg[i];
            LAS unsigned short* vd = (LAS unsigned short*)(Vt + (schk * 8) * 144 + key * 2);
            vd[0 * 72] = (unsigned short)(vv.x & 0xffffu); vd[1 * 72] = (unsigned short)(vv.x >> 16); vd[2 * 72] = (unsigned short)(vv.y & 0xffffu); vd[3 * 72] = (unsigned short)(vv.y >> 16);
            vd[4 * 72] = (unsigned short)(vv.z & 0xffffu); vd[5 * 72] = (unsigned short)(vv.z >> 16); vd[6 * 72] = (unsigned short)(vv.w & 0xffffu); vd[7 * 72] = (unsigned short)(vv.w >> 16); }
        if (t + 1 < nt) ATT_ISSUE(t + 1);
        __syncthreads();
        f32x16 p0, p1;
#pragma unroll
        for (int r = 0; r < 16; ++r) { p0[r] = 0.f; p1[r] = 0.f; }
#pragma unroll
        for (int s = 0; s < 8; ++s) { const bf16x8 k0 = *(const LAS bf16x8*)(Ks + n * 272 + (16 * s + 8 * hi) * 2); const bf16x8 k1 = *(const LAS bf16x8*)(Ks + (32 + n) * 272 + (16 * s + 8 * hi) * 2);
            p0 = __builtin_amdgcn_mfma_f32_32x32x16_bf16(k0, qf[s], p0, 0, 0, 0); p1 = __builtin_amdgcn_mfma_f32_32x32x16_bf16(k1, qf[s], p1, 0, 0, 0); }
        if (lmask) {
#pragma unroll
            for (int r = 0; r < 16; ++r) { const int kp = kpos0 + crow(r, hi); int d0 = qpos - kp; d0 = d0 < 0 ? -d0 : d0; int d1 = qpos - kp - 32; d1 = d1 < 0 ? -d1 : d1;
                if (d0 > 128) p0[r] = -1e30f; if (d1 > 128) p1[r] = -1e30f; } }
        float rm = fmaxf(p0[0], p1[0]);
#pragma unroll
        for (int r = 1; r < 16; ++r) rm = fmaxf(rm, fmaxf(p0[r], p1[r]));
        rm = fmaxf(rm, __shfl_xor(rm, 32));
        const float mn = fmaxf(mrun, rm); const float f = __builtin_amdgcn_exp2f(mrun - mn); mrun = mn;
        float ls = 0.f;
#pragma unroll
        for (int r = 0; r < 16; ++r) { p0[r] = __builtin_amdgcn_exp2f(p0[r] - mn); p1[r] = __builtin_amdgcn_exp2f(p1[r] - mn); ls += p0[r] + p1[r]; }
        l = l * f + ls;
        if (__any(f != 1.f)) {
            if (hi == 0) wsf[n] = f;
            asm volatile("s_waitcnt lgkmcnt(0)" ::: "memory");
#pragma unroll
            for (int r = 0; r < 16; ++r) { const float fr_ = wsf[crow(r, hi)];
#pragma unroll
                for (int d = 0; d < 4; ++d) o[d][r] *= fr_; }
        }
        bf16x8 pa[4];
        { u32x4 t0, t1, t2, t3;
          t0.x = cvt_pk_bf16(p0[0], p0[1]); t0.y = cvt_pk_bf16(p0[2], p0[3]); t0.z = cvt_pk_bf16(p0[4], p0[5]); t0.w = cvt_pk_bf16(p0[6], p0[7]);
          t1.x = cvt_pk_bf16(p0[8], p0[9]); t1.y = cvt_pk_bf16(p0[10], p0[11]); t1.z = cvt_pk_bf16(p0[12], p0[13]); t1.w = cvt_pk_bf16(p0[14], p0[15]);
          t2.x = cvt_pk_bf16(p1[0], p1[1]); t2.y = cvt_pk_bf16(p1[2], p1[3]); t2.z = cvt_pk_bf16(p1[4], p1[5]); t2.w = cvt_pk_bf16(p1[6], p1[7]);
          t3.x = cvt_pk_bf16(p1[8], p1[9]); t3.y = cvt_pk_bf16(p1[10], p1[11]); t3.z = cvt_pk_bf16(p1[12], p1[13]); t3.w = cvt_pk_bf16(p1[14], p1[15]);
          pa[0] = __builtin_bit_cast(bf16x8, t0); pa[1] = __builtin_bit_cast(bf16x8, t1); pa[2] = __builtin_bit_cast(bf16x8, t2); pa[3] = __builtin_bit_cast(bf16x8, t3); }
#pragma unroll
        for (int d = 0; d < 4; ++d)
#pragma unroll
            for (int s = 0; s < 4; ++s) { const LAS unsigned char* vp = Vt + (32 * d + n) * 144 + (16 * s + 4 * hi) * 2;
                const u32x2 lo = *(const LAS u32x2*)vp, hi2 = *(const LAS u32x2*)(vp + 16);
                const u32x4 bw = (u32x4){lo.x, lo.y, hi2.x, hi2.y};
                o[d] = __builtin_amdgcn_mfma_f32_32x32x16_bf16(pa[s], __builtin_bit_cast(bf16x8, bw), o[d], 0, 0, 0); }
    }
#undef ATT_SRC
#undef ATT_ISSUE
    l += __shfl_xor(l, 32);
    if (hi == 0) wsf[32 + n] = 1.f / l;
    asm volatile("s_waitcnt lgkmcnt(0)" ::: "memory");
#pragma unroll
    for (int r = 0; r < 16; ++r) { const float iv = wsf[32 + crow(r, hi)]; bf16_t* op = ZO + (size_t)(rb + qloc + crow(r, hi)) * 2048 + 1024 + head * 128 + n;
#pragma unroll
        for (int d = 0; d < 4; ++d) op[32 * d] = (bf16_t)(cvt_pk_bf16(o[d][r] * iv, 0.f) & 0xffffu); }
}

__device__ __forceinline__ float gelu_tanh(float y) { const float t = 1.5957691216057308f * (y + 0.044715f * y * y * y); return y * __builtin_amdgcn_rcpf(1.f + __expf(-t)); }
__device__ __forceinline__ f32x4 gelu4(f32x4 v) { return (f32x4){gelu_tanh(v[0]), gelu_tanh(v[1]), gelu_tanh(v[2]), gelu_tanh(v[3])}; }
__device__ __forceinline__ void ssm_consts(const Args& a, int gi, int n, int hi, float (&lr)[2], float (&li)[2], bf16x8 (&Bf)[4], bf16x8 (&Cf)[8]) {
    const float dt = __expf(a.in[15][gi]);
    float kr[2], ki[2];
#pragma unroll
    for (int st = 0; st < 2; ++st) { const int p = n + 32 * st; const float lre = a.in[13][gi * 64 + p], lim = a.in[14][gi * 64 + p];
        const float mag = __expf(lre * dt); float s, c; sincos_rr(lim * dt, s, c); lr[st] = mag * c; li[st] = mag * s;
        const float den = 1.f / (lre * lre + lim * lim), nr = lr[st] - 1.f; kr[st] = (nr * lre + li[st] * lim) * den; ki[st] = (li[st] * lre - nr * lim) * den; }
#pragma unroll
    for (int nb = 0; nb < 4; ++nb) { const int st = nb & 1, part = nb >> 1, p = n + 32 * st; const float* br = a.in[16] + (size_t)(gi * 64 + p) * 16 + 8 * hi; const float* bi = a.in[17] + (size_t)(gi * 64 + p) * 16 + 8 * hi;
        float v[8];
#pragma unroll
        for (int j = 0; j < 8; ++j) v[j] = part == 0 ? kr[st] * br[j] - ki[st] * bi[j] : kr[st] * bi[j] + ki[st] * br[j];
        u32x4 t; t.x = cvt_pk_bf16(v[0], v[1]); t.y = cvt_pk_bf16(v[2], v[3]); t.z = cvt_pk_bf16(v[4], v[5]); t.w = cvt_pk_bf16(v[6], v[7]); Bf[nb] = __builtin_bit_cast(bf16x8, t); }
#pragma unroll
    for (int s = 0; s < 8; ++s) { float v[8];
#pragma unroll
        for (int j = 0; j < 8; ++j) { const int np = 4 * s + 2 * hi + (j >> 2), q = j & 3, p = np + 32 * (q & 1); const int cc = n & 15;
            const float x = q < 2 ? a.in[18][(size_t)(gi * 16 + cc) * 64 + p] : -a.in[19][(size_t)(gi * 16 + cc) * 64 + p]; v[j] = n < 16 ? x : 0.f; }
        u32x4 t; t.x = cvt_pk_bf16(v[0], v[1]); t.y = cvt_pk_bf16(v[2], v[3]); t.z = cvt_pk_bf16(v[4], v[5]); t.w = cvt_pk_bf16(v[6], v[7]); Cf[s] = __builtin_bit_cast(bf16x8, t); }
}
template <bool FULL> __device__ __forceinline__ void ssm_chunk(const bf16x8 Af, const bf16x8 (&Bf)[4], const bf16x8 (&Cf)[8], const float (&lr)[2], const float (&li)[2], float (&hr)[2], float (&hm)[2], LAS unsigned char* hl, int n, int hi, f32x16& Y) {
    f32x16 D[4];
#pragma unroll
    for (int nb = 0; nb < 4; ++nb) {
#pragma unroll
        for (int r = 0; r < 16; ++r) D[nb][r] = 0.f;
        D[nb] = __builtin_amdgcn_mfma_f32_32x32x16_bf16(Af, Bf[nb], D[nb], 0, 0, 0); }
    typedef float f32x2 __attribute__((ext_vector_type(2)));
    const f32x2 lr2 = (f32x2){lr[0], lr[1]}, li2 = (f32x2){li[0], li[1]}; f32x2 hr2 = (f32x2){hr[0], hr[1]}, hm2 = (f32x2){hm[0], hm[1]};
#pragma unroll
    for (int r = 0; r < 16; ++r) {
        const f32x2 dre = (f32x2){D[0][r], D[1][r]}, dim = (f32x2){D[2][r], D[3][r]};
        const f32x2 nr = __builtin_elementwise_fma(lr2, hr2, __builtin_elementwise_fma(-li2, hm2, dre));
        const f32x2 ni = __builtin_elementwise_fma(lr2, hm2, __builtin_elementwise_fma(li2, hr2, dim));
        hr2 = nr; hm2 = ni;
        if (FULL) { u32x2 pk; pk.x = cvt_pk_bf16(hr2[0], hr2[1]); pk.y = cvt_pk_bf16(hm2[0], hm2[1]); *(LAS u32x2*)(hl + crow(r, hi) * 272 + n * 8) = pk; } }
    hr[0] = hr2[0]; hr[1] = hr2[1]; hm[0] = hm2[0]; hm[1] = hm2[1];
    if (FULL) {
#pragma unroll
        for (int r = 0; r < 16; ++r) Y[r] = 0.f;
#pragma unroll
        for (int s = 0; s < 8; ++s) { const bf16x8 af = *(const LAS bf16x8*)(hl + n * 272 + (16 * s + 8 * hi) * 2); Y = __builtin_amdgcn_mfma_f32_32x32x16_bf16(af, Cf[s], Y, 0, 0, 0); }
    }
}
__device__ __forceinline__ void ssm_prompt_block(const Args& a, LAS unsigned char* lds, int task) {
    const int tid = threadIdx.x, lane = tid & 63, w = __builtin_amdgcn_readfirstlane(tid >> 6);
    LAS unsigned char* hl = lds + 40960 + w * 8704;
    const int d = w & 1, t2 = task * 4 + (w >> 1), g = t2 & 63, pair = t2 >> 6;
    const int n = lane & 31, hi = lane >> 5;
    const int ahalf = (n >> 2) & 1, atau = (n & 3) + 4 * (n >> 3);
    const int rbA = (2 * pair + ahalf) * 256, rbO = (2 * pair + hi) * 256, bO = 2 * pair + hi;
    const bf16_t* U = (const bf16_t*)(a.ws + WS_U); float* YF = (float*)(a.ws + WS_YF); bf16_t* Z = (bf16_t*)(a.ws + WS_Z);
    float* YBh = (float*)(a.ws + (pair < 8 ? WS_YBP0 : WS_YBP1)); const int hoff = pair < 8 ? 0 : 4096;
    float* out_re = a.out + 25165824; float* out_im = out_re + 262144;
    const int col = g * 16 + (n & 15);
    {
        const int gi = d * 64 + g;
        float lr[2], li[2]; bf16x8 Bf[4], Cf[8];
        ssm_consts(a, gi, n, hi, lr, li, Bf, Cf);
        float hr[2] = {0.f, 0.f}, hm[2] = {0.f, 0.f};
        const bf16_t* ua = U + (size_t)rbA * 1024 + g * 16 + 8 * hi;
        float* yo = (d == 0 ? YF + ((size_t)g * 10240 + rbO) * 16 : YBh + ((size_t)g * 4096 + rbO - hoff) * 16) + (n & 15);
        for (int grp = 0; grp < 2; ++grp) {
            bf16x8 A8[8];
#pragma unroll
            for (int c = 0; c < 8; ++c) { const int tk = 16 * (8 * grp + c) + atau; A8[c] = *(const bf16x8*)(ua + (size_t)(d == 0 ? tk : 255 - tk) * 1024); }
#pragma unroll
            for (int c = 0; c < 8; ++c) { const int ch = 8 * grp + c;
                f32x16 Y;
                ssm_chunk<true>(A8[c], Bf, Cf, lr, li, hr, hm, hl, n, hi, Y);
                if (n < 16) {
#pragma unroll
                    for (int r = 0; r < 16; ++r) { const int tok = d == 0 ? 16 * ch + r : 255 - (16 * ch + r); yo[tok * 16] = Y[r]; } } }
        }
#pragma unroll
        for (int st = 0; st < 2; ++st) { const size_t si = ((size_t)(bO * 2 + d) * 64 + g) * 64 + n + 32 * st; out_re[si] = hr[st]; out_im[si] = hm[st]; }
    }
    asm volatile("s_waitcnt vmcnt(0)" ::: "memory");
    __syncthreads();
    { const int c4 = (lane & 3) * 4; const f32x4 dc = *(const f32x4*)(a.in[20] + g * 16 + c4); const int row0 = (2 * pair + (w & 1)) * 256 + (lane >> 2);
      for (int b2 = 0; b2 < 2; ++b2) { f32x4 yf[8], yb[8]; u32x2 uu[8];
#pragma unroll
          for (int i = 0; i < 8; ++i) { const int row = row0 + (b2 * 8 + i) * 16; yf[i] = *(const f32x4*)(YF + ((size_t)g * 10240 + row) * 16 + c4); yb[i] = *(const f32x4*)(YBh + ((size_t)g * 4096 + row - hoff) * 16 + c4);
              uu[i] = *(const u32x2*)(U + (size_t)row * 1024 + g * 16 + c4); }
#pragma unroll
          for (int i = 0; i < 8; ++i) { const int row = row0 + (b2 * 8 + i) * 16; *(u32x2*)(Z + (size_t)row * 1024 + g * 16 + c4) = pack4(gelu4(unpack4(uu[i]) * dc + yf[i] + yb[i])); } } }
}
__device__ __forceinline__ void ssm_latent_block(const Args& a, LAS unsigned char* lds, int g) {
    const int tid = threadIdx.x, lane = tid & 63, w = __builtin_amdgcn_readfirstlane(tid >> 6), n = lane & 31, hi = lane >> 5;
    const int seg = w & 3, d = w >> 2, gi = d * 64 + g;
    LAS unsigned char* hl = lds + 40960 + w * 8704; LAS float* Ex = (LAS float*)(lds + 40960 + 8 * 8704);
    const int ahalf = (n >> 2) & 1, atau = (n & 3) + 4 * (n >> 3);
    const bf16_t* U = (const bf16_t*)(a.ws + WS_U); float* YF = (float*)(a.ws + WS_YF); float* YB = (float*)(a.ws + WS_YBL); bf16_t* Z = (bf16_t*)(a.ws + WS_Z);
    float lr[2], li[2]; bf16x8 Bf[4], Cf[8];
    ssm_consts(a, gi, n, hi, lr, li, Bf, Cf);
    float pr[2], pi[2];
#pragma unroll
    for (int st = 0; st < 2; ++st) { float x = lr[st], y = li[st];
#pragma unroll
        for (int k = 0; k < 8; ++k) { const float nx = x * x - y * y, ny = 2.f * x * y; x = nx; y = ny; }
        pr[st] = x; pi[st] = y; }
    const bf16_t* ua = U + (size_t)(NPROMPT + ahalf * 1024 + seg * 256) * 1024 + g * 16 + 8 * hi;
    f32x16 Y;
    float hr[2] = {0.f, 0.f}, hm[2] = {0.f, 0.f};
    for (int grp = 0; grp < 2; ++grp) { bf16x8 A8[8];
#pragma unroll
        for (int c = 0; c < 8; ++c) { const int tk = 16 * (8 * grp + c) + atau; A8[c] = *(const bf16x8*)(ua + (size_t)(d == 0 ? tk : 255 - tk) * 1024); }
#pragma unroll
        for (int c = 0; c < 8; ++c) ssm_chunk<false>(A8[c], Bf, Cf, lr, li, hr, hm, hl, n, hi, Y); }
#pragma unroll
    for (int st = 0; st < 2; ++st) { LAS float* e = Ex + ((((d * 4 + seg) * 2 + hi) * 64) + n + 32 * st) * 2; e[0] = hr[st]; e[1] = hm[st]; }
    __syncthreads();
#pragma unroll
    for (int st = 0; st < 2; ++st) { const size_t si = ((size_t)(hi * 2 + d) * 64 + g) * 64 + n + 32 * st; float x = a.in[4][si], y = a.in[5][si];
        for (int k = 0; k < 3; ++k) { const int s = d == 0 ? k : 3 - k; const bool go = d == 0 ? (s < seg) : (s > seg);
            if (go) { const LAS float* e = Ex + ((((d * 4 + s) * 2 + hi) * 64) + n + 32 * st) * 2; const float nx = pr[st] * x - pi[st] * y + e[0], ny = pr[st] * y + pi[st] * x + e[1]; x = nx; y = ny; } }
        hr[st] = x; hm[st] = y; }
    { float* yo = (d == 0 ? YF + ((size_t)g * 10240 + NPROMPT + hi * 1024 + seg * 256) * 16 : YB + ((size_t)g * 2048 + hi * 1024 + seg * 256) * 16) + (n & 15);
      for (int grp = 0; grp < 2; ++grp) { bf16x8 A8[8];
#pragma unroll
          for (int c = 0; c < 8; ++c) { const int tk = 16 * (8 * grp + c) + atau; A8[c] = *(const bf16x8*)(ua + (size_t)(d == 0 ? tk : 255 - tk) * 1024); }
#pragma unroll
          for (int c = 0; c < 8; ++c) { const int ch = 8 * grp + c;
              ssm_chunk<true>(A8[c], Bf, Cf, lr, li, hr, hm, hl, n, hi, Y);
              if (n < 16) {
#pragma unroll
                  for (int r = 0; r < 16; ++r) { const int tok = d == 0 ? 16 * ch + r : 255 - (16 * ch + r); yo[tok * 16] = Y[r]; } } } } }
    __threadfence(); __syncthreads();
    { const int c4 = (tid & 3) * 4; const f32x4 dc = *(const f32x4*)(a.in[20] + g * 16 + c4);
      for (int b2 = 0; b2 < 2; ++b2) { f32x4 yf[8], yb[8]; u32x2 uu[8];
#pragma unroll
          for (int i = 0; i < 8; ++i) { const int rl = (tid >> 2) + (b2 * 8 + i) * 128; yf[i] = *(const f32x4*)(YF + ((size_t)g * 10240 + NPROMPT + rl) * 16 + c4); yb[i] = *(const f32x4*)(YB + ((size_t)g * 2048 + rl) * 16 + c4);
              uu[i] = *(const u32x2*)(U + (size_t)(NPROMPT + rl) * 1024 + g * 16 + c4); }
#pragma unroll
          for (int i = 0; i < 8; ++i) { const int rl = (tid >> 2) + (b2 * 8 + i) * 128; *(u32x2*)(Z + (size_t)(NPROMPT + rl) * 1024 + g * 16 + c4) = pack4(gelu4(unpack4(uu[i]) * dc + yf[i] + yb[i])); } } }
    __syncthreads();
}

#define XB_TMO      128
#define XB_XCNT(j)  (256  + 64 * (j))
#define XB_XSUB(j)  (1280 + 64 * (j))
#define XB_XGEN(j)  (2304 + 64 * (j))
#define XB_TOP      3328
#define XB_TOPGEN   3392
#define XCD_BAR_WORDS 3456
#define XB_SPIN_CAP (1u << 22)
__device__ __forceinline__ unsigned xb_ld(unsigned* p)              { return __hip_atomic_load(p, __ATOMIC_RELAXED, __HIP_MEMORY_SCOPE_AGENT); }
__device__ __forceinline__ unsigned xb_add(unsigned* p, unsigned v) { return __hip_atomic_fetch_add(p, v, __ATOMIC_RELAXED, __HIP_MEMORY_SCOPE_AGENT); }
__device__ __forceinline__ unsigned xb_xcc_id() { return (unsigned)__builtin_amdgcn_s_getreg((3 << 11) | 20) & 0xFu; }
#define XB_SPIN(cond, bar) do { unsigned _sp = 0; while (cond) { __builtin_amdgcn_s_sleep(1); \
    if ((++_sp & 255u) == 0u) { if (xb_ld(&(bar)[XB_TMO])) break; if (_sp > XB_SPIN_CAP) { atomicAdd(&(bar)[XB_TMO], 1u); break; } } } } while (0)
struct XcdBarrier { unsigned* bar; unsigned x; volatile LAS unsigned* st; };
__device__ __forceinline__ XcdBarrier xcd_barrier_post(unsigned* bar, volatile LAS unsigned* st) {
    XcdBarrier b; b.bar = bar; b.x = xb_xcc_id(); b.st = st;
    if (threadIdx.x == 0) (void)xb_add(&bar[XB_XCNT(b.x)], 1u);
    return b;
}
__device__ __forceinline__ void xcd_barrier_complete(unsigned* bar, unsigned x, unsigned& nloc, unsigned& nx) {
    const unsigned G = gridDim.x * gridDim.y * gridDim.z;
    unsigned sum, cnt, mine, sp = 0u;
    for (;;) {
        sum = 0u; cnt = 0u; mine = 0u;
#pragma unroll
        for (unsigned j = 0; j < 16; ++j) { const unsigned c = xb_ld(&bar[XB_XCNT(j)]); sum += c; cnt += (c > 0u) ? 1u : 0u; mine = (j == x) ? c : mine; }
        if (sum == G) break;
        __builtin_amdgcn_s_sleep(1);
        if ((++sp & 255u) == 0u) { if (xb_ld(&bar[XB_TMO])) break; if (sp > XB_SPIN_CAP) { atomicAdd(&bar[XB_TMO], 1u); break; } }
    }
    nloc = mine > 0u ? mine : 1u; nx = cnt > 0u ? cnt : 1u;
}
__device__ __forceinline__ void xcd_barrier(const XcdBarrier& b) {
    asm volatile("s_waitcnt vmcnt(0)" ::: "memory");
    __syncthreads();
    if (threadIdx.x == 0) {
        unsigned* bar = b.bar;
        __builtin_amdgcn_s_waitcnt(0);
        unsigned nloc = b.st[0], nx = b.st[1];
        if (nloc == 0u) { xcd_barrier_complete(bar, b.x, nloc, nx); b.st[0] = nloc; b.st[1] = nx; }
        const unsigned old = xb_add(&bar[XB_XSUB(b.x)], 1u);
        const unsigned gen = old / nloc;
        if (old + 1u == (gen + 1u) * nloc) {
            __builtin_amdgcn_fence(__ATOMIC_RELEASE, "agent");
            asm volatile("s_waitcnt vmcnt(0)" ::: "memory");
            const unsigned og = xb_add(&bar[XB_TOP], 1u);
            const unsigned tg = og / nx;
            if (og + 1u == (tg + 1u) * nx) xb_add(&bar[XB_TOPGEN], 1u);
            else XB_SPIN(xb_ld(&bar[XB_TOPGEN]) == tg, bar);
            __builtin_amdgcn_fence(__ATOMIC_ACQUIRE, "agent");
            xb_add(&bar[XB_XGEN(b.x)], 1u);
            asm volatile("s_waitcnt vmcnt(0)" ::: "memory");
        } else {
            XB_SPIN(xb_ld(&bar[XB_XGEN(b.x)]) == gen, bar);
            __builtin_amdgcn_fence(__ATOMIC_ACQUIRE, "agent");
            asm volatile("s_waitcnt vmcnt(0)" ::: "memory");
        }
    }
    __syncthreads();
}

__global__ void __launch_bounds__(512, 2) mk_fwd(Args a) {
    extern __shared__ __attribute__((aligned(16))) unsigned char lds_raw[];
    LAS unsigned char* lds = (LAS unsigned char*)lds_raw;
    cg::grid_group grid = cg::this_grid();
    const int lo = a.ph_lo, hi = a.ph_hi;
    const int tid = threadIdx.x, lane = tid & 63, wave = __builtin_amdgcn_readfirstlane(tid >> 6);
    const int G = gridDim.x;
#define IN(k) (lo <= (k) && (k) < hi)
#define SEAM(k) do { if (IN(k) && IN((k) + 1)) { xcd_barrier(xbar); } } while (0)
    unsigned char* ws = a.ws;
    float* mod = (float*)(ws + WS_MOD);
    if (lo > 1000) grid.sync();
    volatile LAS unsigned* xst = (volatile LAS unsigned*)(lds + LDS_EX + 16384);
    if (tid < 2) xst[tid] = 0u;
    __syncthreads();
    XcdBarrier xbar; xbar.bar = (unsigned*)(ws + WS_BAR); xbar.x = 0; xbar.st = xst;
    if (hi - lo > 1) xbar = xcd_barrier_post((unsigned*)(ws + WS_BAR), xst);

    if (IN(0)) { phase0(a, lds); } SEAM(0);
    if (IN(1)) { for (int rep_ = 0; rep_ < P1_REP; ++rep_) { if (rep_) __syncthreads(); phase1(a, lds); } } SEAM(1);
    if (IN(2)) {
        pg8::Gemm g{(const bf16_t*)(ws + WS_XM), (const bf16_t*)(ws + WS_WIN), 2048, 2048, nullptr, nullptr};
        EpiWin E{(bf16_t*)(ws + WS_U), (bf16_t*)(ws + WS_Q), (bf16_t*)(ws + WS_K), (bf16_t*)(ws + WS_V), (bf16_t*)(ws + WS_GS), (bf16_t*)(ws + WS_GA),
                 a.out + 20971520, a.out + 20971520 + 2097152, (const float*)(ws + WS_ROPEC), (const float*)(ws + WS_ROPES)};
        if (G == 256) { WinOrder S{G, (int)blockIdx.x}; pg8::gemm_phase(lds, g, S, E); }
        else { pg8::StaticOrder S; S.init(40, 26, G, (int)blockIdx.x, 32, 1); pg8::gemm_phase(lds, g, S, E); }
    } SEAM(2);
    if (IN(3)) {
        volatile LAS unsigned* qs = (volatile LAS unsigned*)(lds + LDS_EX + 16384 + 16);
        unsigned* qctr = (unsigned*)(ws + WS_QCTR);
        const int n_g = (G == 256) ? 16 : 0; const int e0 = n_g, e1 = e0 + 64, e2 = e1 + 256, e3 = e2 + 64, e4 = e3 + 256;
        int t = (int)blockIdx.x;
#define QNEXT() do { __syncthreads(); if (tid == 0) qs[0] = (unsigned)G + atomicAdd(qctr, 1u); __syncthreads(); t = (int)qs[0]; } while (0)
        if (G == 256) {
            pg8::Gemm g{(const bf16_t*)(ws + WS_XM), (const bf16_t*)(ws + WS_WIN), 2048, 2048, nullptr, nullptr};
            EpiWin E{(bf16_t*)(ws + WS_U), (bf16_t*)(ws + WS_Q), (bf16_t*)(ws + WS_K), (bf16_t*)(ws + WS_V), (bf16_t*)(ws + WS_GS), (bf16_t*)(ws + WS_GA),
                     a.out + 20971520, a.out + 20971520 + 2097152, (const float*)(ws + WS_ROPEC), (const float*)(ws + WS_ROPES)};
            while (t < e0) { win_unit(lds, g, E, t); QNEXT(); }
        }
        while (t < e1) { ssm_latent_block(a, lds, t - e0); QNEXT(); }
        while (t < e2) { ssm_prompt_block(a, lds, t - e1); QNEXT(); }
        while (t < e3) { attn_unit(a, lds, t - e2); QNEXT(); }
        while (t < e4) { attn_unit(a, lds, 64 + (t - e3)); QNEXT(); }
        while (t < e4 + 144) { __syncthreads(); for (int k = 0; k < 4; ++k) small_weight_item(a, (LAS float*)(lds + wave * 8704), ((t - e4) * 4 + k) * 8 + wave, lane); QNEXT(); }
#undef QNEXT
        shv2_rows(a);
    } SEAM(3);
    if (IN(4)) {
        pg8::Gemm g{(const bf16_t*)(ws + WS_Z), (const bf16_t*)(ws + WS_WGLU), 1024, 1024, nullptr, nullptr}; pg8::StaticOrder S; S.init(40, 4, G, (int)blockIdx.x, 16, 1);
        EpiGlu E{(const bf16_t*)(ws + WS_Z), (bf16_t*)(ws + WS_ZO)};
        pg8::gemm_phase(lds, g, S, E);
        { Unit u0; const int nbusy = S.nwg < G ? S.nwg : G;
          const bool idle = !S.next(0, u0); const int nidle = G - nbusy;
          if (nidle > 0 ? idle : true) { const int wid0 = nidle > 0 ? ((int)blockIdx.x - nbusy) * 8 + wave : (int)blockIdx.x * 8 + wave, nw = (nidle > 0 ? nidle : G) * 8;
              __syncthreads();
              for (int it = wid0; it < 88 * 64; it += nw) transpose_item<0>(a.in[29], 2048, (bf16_t*)(ws + WS_WDN), DFF, 0, (LAS float*)(lds + wave * 8704), it, lane, nullptr, nullptr); } }
    } SEAM(4);
    if (IN(5)) {
        pg8::Gemm g{(const bf16_t*)(ws + WS_ZO), (const bf16_t*)(ws + WS_WM), 2048, 2048, (float*)(ws + 128 * MiB), (unsigned*)(ws + WS_SPCNT) + 256}; PairOrder S; S.S.init(40, 8, G, (int)blockIdx.x, 32, 1); S.S.qm = true;
        EpiMerged E{(const bf16_t*)(ws + WS_GS), (const bf16_t*)(ws + WS_GA), (bf16_t*)(ws + WS_MERGED)};
        pg8::gemm_phase(lds, g, S, E);
    } SEAM(5);
    if (IN(6)) {
        pg8::Gemm g{(const bf16_t*)(ws + WS_MERGED), (const bf16_t*)(ws + WS_WOUT), 2048, 2048, (float*)(ws + 160 * MiB), (unsigned*)(ws + WS_SPCNT) + 512}; pg8::StaticOrder S; S.init(40, 8, G, (int)blockIdx.x, 32, 1); S.qm = true;
        EpiRes<true> E{a.in[0], a.in[1], nullptr, true, a.out, mod, 2 * 2048, (const float*)(ws + WS_G2), (bf16_t*)(ws + WS_XM), (float*)(ws + WS_RS1), nullptr};
        pg8::gemm_phase(lds, g, S, E);
    } SEAM(6);
    if (IN(7)) {
        pg8::Gemm g{(const bf16_t*)(ws + WS_XM), (const bf16_t*)(ws + WS_WUP), 2048, LDWUP, (float*)(ws + 288 * MiB), (unsigned*)(ws + WS_SPCNT) + 768}; pg8::StaticOrder S; S.init(40, 44, G, (int)blockIdx.x, 32, 1);
        EpiUp E{(const float*)(ws + WS_RS1), (const float*)(ws + WS_SHV2), a.in[27], a.in[28], (bf16_t*)(ws + WS_ACT), (float*)(ws + WS_HBP), (float*)(ws + WS_HBH)};
        pg8::gemm_phase(lds, g, S, E);
    } SEAM(7);
    if (IN(8)) {
        {
          const float* hbp = (const float*)(ws + WS_HBP); const float* hbh = (const float*)(ws + WS_HBH); const float* cw = a.in[27]; bf16_t* ACT = (bf16_t*)(ws + WS_ACT);
          const bool own = (G == 256); const int c_ = (int)blockIdx.x; const int t_own = (c_ >> 2) & 7, q_lo = (c_ & 3) * 1408;
          const int n_it = own ? 2 * 1408 : 16 * DFF;
          for (int idx = own ? tid : blockIdx.x * 512 + tid; idx < n_it; idx += own ? 512 : G * 512) {
              int tw, q; if (own) { const int which_ = idx / 1408; tw = t_own * 2 + which_; q = q_lo + (idx - which_ * 1408); } else { tw = idx / DFF; q = idx - tw * DFF; }
              const int t = tw >> 1, which = tw & 1, j = t & 3;
              if ((which == 0 && j == 0) || (which == 1 && j == 3)) continue;
              const int nbr = which == 0 ? (t - 1) * 2 + 1 : (t + 1) * 2; const float* wt = cw + (which == 0 ? 0 : 2 * NUP);
              const float av = hbp[(size_t)tw * NUP + q] + wt[q] * hbh[(size_t)nbr * NUP + q];
              const float bv = hbp[(size_t)tw * NUP + DFF + q] + wt[DFF + q] * hbh[(size_t)nbr * NUP + DFF + q];
              ACT[(size_t)(NPROMPT + t * 256 + (which ? 255 : 0)) * DFF + q] = (bf16_t)(cvt_pk_bf16(av * sigmoidf(av) * bv, 0.f) & 0xffffu); }
          asm volatile("s_waitcnt vmcnt(0)" ::: "memory");
          if (own) __syncthreads(); else if (hi - lo > 1) xcd_barrier(xbar); }
        pg8::Gemm g{(const bf16_t*)(ws + WS_ACT), (const bf16_t*)(ws + WS_WDN), DFF, DFF, nullptr, nullptr}; DownOrder S; S.S.init(40, 8, G, (int)blockIdx.x, 88, 1); S.split = (G == 256);
        EpiDown E{a.out, mod, (float*)(ws + WS_RS2), (float*)(ws + WS_PART8), a.in[30], (float*)(ws + WS_XCH), (unsigned*)(ws + WS_PCNT), G == 256};
        pg8::gemm_phase(lds, g, S, E);
    } SEAM(8);
    if (IN(9)) {
        const int gw = blockIdx.x * 8 + wave, NGW = G * 8; const float* rs2 = (const float*)(ws + WS_RS2); const float* fg = a.in[30]; const bool split = (G == 256);
        for (int m = (split ? NPROMPT : 0) + gw; m < MT; m += NGW) { float* yr = a.out + (size_t)m * DM;
            f32x4 v[8];
#pragma unroll
            for (int j = 0; j < 8; ++j) v[j] = *(const f32x4*)(yr + 4 * lane + 256 * j);
            float rstd;
            if (split && m >= NPROMPT) { const float* pp = (const float*)(ws + WS_PART8) + (size_t)(m - NPROMPT) * 2048 + 4 * lane; float ss = 0.f;
#pragma unroll
                for (int j = 0; j < 8; ++j) { v[j] += (*(const f32x4*)(pp + 256 * j) + *(const f32x4*)(pp + 2048 * 2048 + 256 * j)) + (*(const f32x4*)(pp + 2 * 2048 * 2048 + 256 * j) + *(const f32x4*)(pp + 3 * 2048 * 2048 + 256 * j));
                    ss += (v[j][0] * v[j][0] + v[j][1] * v[j][1]) + (v[j][2] * v[j][2] + v[j][3] * v[j][3]); }
                rstd = rsqrtf(wave_sum(ss) * (1.f / DM) + EPS); }
            else rstd = rsqrtf(rs2[m] * (1.f / DM) + EPS);
#pragma unroll
            for (int j = 0; j < 8; ++j) { const int col = 4 * lane + 256 * j; *(f32x4*)(yr + col) = v[j] * rstd * *(const f32x4*)(fg + col); } }
    }
#undef IN
#undef SEAM
}

extern "C" void kernel_launch(void* const* d_in, const int* in_sizes, int n_in, void* d_out, int out_size, void* d_ws, size_t ws_size, hipStream_t stream) {
    static int grid = 0;
    if (grid == 0) {
        if (n_in != 31 || out_size != 25690112 || ws_size < WS_END) { fprintf(stderr, "kernel_launch: unexpected shapes: n_in %d out %d ws %zu (need %zu)\n", n_in, out_size, ws_size, (size_t)WS_END); grid = -1; return; }
        int dev = 0, cus = 0, per_cu = 0;
        hipGetDevice(&dev); hipDeviceGetAttribute(&cus, hipDeviceAttributeMultiprocessorCount, dev);
        hipFuncSetAttribute((const void*)mk_fwd, hipFuncAttributeMaxDynamicSharedMemorySize, LDS_BYTES);
        hipOccupancyMaxActiveBlocksPerMultiprocessor(&per_cu, (const void*)mk_fwd, 512, LDS_BYTES);
        if (per_cu < 1) { fprintf(stderr, "kernel_launch: occupancy query reports %d blocks per CU\n", per_cu); (void)hipGetLastError(); grid = -1; return; }
        grid = cus * per_cu;
    }
    if (grid < 0) return;
    hipMemsetAsync(d_ws, 0, ZERO_BYTES, stream);
    Args a{};
    for (int i = 0; i < 31; ++i) a.in[i] = (const float*)d_in[i];
    a.out = (float*)d_out; a.ws = (unsigned char*)d_ws;
#if MK_ONE_LAUNCH
    a.ph_lo = 0; a.ph_hi = NPH;
    { void* args[] = {&a}; hipError_t e = hipLaunchCooperativeKernel((const void*)mk_fwd, dim3(grid), dim3(512), args, LDS_BYTES, stream);
      if (e != hipSuccess) fprintf(stderr, "cooperative launch failed: %s (grid %d)\n", hipGetErrorString(e), grid); }
#else
    for (int p = 0; p < NPH; ++p) { a.ph_lo = p; a.ph_hi = p + 1; void* args[] = {&a};
        hipError_t e = hipLaunchCooperativeKernel((const void*)mk_fwd, dim3(grid), dim3(512), args, LDS_BYTES, stream);
        if (e != hipSuccess) { fprintf(stderr, "cooperative launch %d failed: %s (grid %d)\n", p, hipGetErrorString(e), grid); break; } }
#endif
}
```
